# Optimizing an MI355X kernel written in HIP

```python
import math
import jax, jax.numpy as jnp
from jax import lax
import numpy as np

D_MODEL = 1024
BATCH = 8
SEQ = 2048
DEPTH = 1

D_MIX = D_MODEL
D_MLSTM = D_MIX // 2
N_HEADS_MLSTM = 4
HEAD_DIM_MLSTM = D_MLSTM // N_HEADS_MLSTM
D_MOBA = D_MIX - D_MLSTM
N_HEADS_MOBA = 8
HEAD_DIM_MOBA = D_MOBA // N_HEADS_MOBA
CONV_K = 4
MLSTM_CHUNK = 64
MOBA_BLOCK = 256
MOBA_TOPK = 3
MOBA_Q_CHUNK = 16
EPS = 1e-6
SPLIT_SIZES = [D_MLSTM, D_MLSTM, D_MLSTM, D_MLSTM, N_HEADS_MLSTM, N_HEADS_MLSTM, D_MLSTM,
               D_MOBA, D_MOBA, D_MOBA, D_MOBA]
PROJ_DIM = sum(SPLIT_SIZES)

kernel_name = "hymba_mlstm_moba_adaln_layer"


def rms_norm(x, g):
    x32 = x.astype(jnp.float32)
    return x32 * lax.rsqrt(jnp.mean(x32 * x32, axis=-1, keepdims=True) + EPS) * g.astype(jnp.float32)


def to_heads(u, n_heads):
    b, s, _ = u.shape
    return u.reshape(b, s, n_heads, -1).transpose(0, 2, 1, 3)


def causal_short_conv(u, w, bias):
    s = u.shape[1]
    u_pad = jnp.pad(u, ((0, 0), (CONV_K - 1, 0), (0, 0)))
    out = bias.astype(jnp.float32)
    for tap in range(CONV_K):
        out = out + u_pad[:, tap:tap + s] * w[tap].astype(jnp.float32)
    return out


def alibi_slopes(n_heads):
    return jnp.asarray([2.0 ** (-8.0 * (h + 1) / n_heads) for h in range(n_heads)], dtype=jnp.float32)


def mlstm_chunkwise(q, k, v, i_pre, f_pre):
    b_, h_, s_, dh = q.shape
    L = MLSTM_CHUNK
    nc = s_ // L
    k = k * (dh ** -0.5)
    q_c = q.reshape(b_, h_, nc, L, dh)
    k_c = k.reshape(b_, h_, nc, L, dh)
    v_c = v.reshape(b_, h_, nc, L, dh)
    log_f = jax.nn.log_sigmoid(f_pre).reshape(b_, h_, nc, L)
    log_i = i_pre.reshape(b_, h_, nc, L)
    cum_f = jnp.cumsum(log_f, axis=-1)
    f_tot = cum_f[..., -1]
    a = f_tot[..., None] - cum_f + log_i
    a_max = jnp.max(a, axis=-1)
    w = jnp.exp(a - a_max[..., None])
    C_loc = jnp.einsum('bhcs,bhcsv,bhcsk->bhcvk', w, v_c, k_c)
    n_loc = jnp.einsum('bhcs,bhcsk->bhck', w, k_c)

    def step(carry, inp):
        C, n, m = carry
        C_l, n_l, am, ft = inp
        m_new = jnp.maximum(ft + m, am)
        s_old = jnp.exp(ft + m - m_new)
        s_new = jnp.exp(am - m_new)
        C_n = s_old[..., None, None] * C + s_new[..., None, None] * C_l
        n_n = s_old[..., None] * n + s_new[..., None] * n_l
        return (C_n, n_n, m_new), (C, n, m)

    init = (jnp.zeros((b_, h_, dh, dh), jnp.float32), jnp.zeros((b_, h_, dh), jnp.float32),
            jnp.zeros((b_, h_), jnp.float32))
    xs = (C_loc.transpose(2, 0, 1, 3, 4), n_loc.transpose(2, 0, 1, 3),
          a_max.transpose(2, 0, 1), f_tot.transpose(2, 0, 1))
    _, (C_prev, n_prev, m_prev) = lax.scan(step, init, xs)
    C_prev = C_prev.transpose(1, 2, 0, 3, 4)
    n_prev = n_prev.transpose(1, 2, 0, 3)
    m_prev = m_prev.transpose(1, 2, 0)

    causal = jnp.tril(jnp.ones((L, L), dtype=bool))
    D = cum_f[..., :, None] - cum_f[..., None, :] + log_i[..., None, :]
    D = jnp.where(causal, D, -jnp.inf)
    m_inter = cum_f + m_prev[..., None]
    m_t = jnp.maximum(m_inter, jnp.max(D, axis=-1))
    inter_scale = jnp.exp(m_inter - m_t)
    S_qk = jnp.einsum('bhctd,bhcsd->bhcts', q_c, k_c) * jnp.exp(D - m_t[..., None])
    num = (jnp.einsum('bhcts,bhcsd->bhctd', S_qk, v_c)
           + inter_scale[..., None] * jnp.einsum('bhcvk,bhctk->bhctv', C_prev, q_c))
    den = jnp.sum(S_qk, axis=-1) + inter_scale * jnp.einsum('bhck,bhctk->bhct', n_prev, q_c)
    h = num / jnp.maximum(jnp.abs(den), jnp.exp(-m_t))[..., None]
    return h.reshape(b_, h_, s_, dh)


def moba_attention(q, k, v, slopes):
    b_, h_, s_, dh = q.shape
    blk = MOBA_BLOCK
    nb = -(-s_ // blk)
    s_pad = nb * blk
    k_eff = min(MOBA_TOPK, nb)
    pad = ((0, 0), (0, 0), (0, s_pad - s_), (0, 0))
    k_p = jnp.pad(k, pad)
    v_p = jnp.pad(v, pad)
    k_blk = k_p.reshape(b_, h_, nb, blk, dh)
    v_blk = v_p.reshape(b_, h_, nb, blk, dh)
    k_mean = jnp.mean(k_blk, axis=3)
    scale = dh ** -0.5
    qc_n = MOBA_Q_CHUNK
    n_q = s_ // qc_n
    q_chunks = q.reshape(b_, h_, n_q, qc_n, dh).transpose(2, 0, 1, 3, 4)
    b_idx = jnp.arange(b_)[:, None, None, None]
    h_idx = jnp.arange(h_)[None, :, None, None]
    slope = slopes[None, :, None, None]

    def step(args):
        qc, ci = args
        t0 = ci * qc_n
        pos_q = t0 + jnp.arange(qc_n, dtype=jnp.int32)
        j = t0 // blk
        gate = jnp.einsum('bhqd,bhnd->bhqn', qc, k_mean)
        past = jnp.arange(nb, dtype=jnp.int32) < j
        gate = jnp.where(past, gate, -jnp.inf)
        _, sel = lax.top_k(gate, k_eff)
        sel_valid = jnp.arange(k_eff, dtype=jnp.int32) < j
        k_sel = k_blk[b_idx, h_idx, sel]
        v_sel = v_blk[b_idx, h_idx, sel]
        key_pos = sel[..., None] * blk + jnp.arange(blk, dtype=jnp.int32)
        dist = (pos_q[None, None, :, None, None] - key_pos).astype(jnp.float32)
        sc_sel = jnp.einsum('bhqd,bhqnkd->bhqnk', qc, k_sel) * scale - slope[..., None] * jnp.abs(dist)
        sc_sel = jnp.where(sel_valid[:, None], sc_sel, -jnp.inf)
        k_own = lax.dynamic_slice_in_dim(k_p, j * blk, blk, axis=2)
        v_own = lax.dynamic_slice_in_dim(v_p, j * blk, blk, axis=2)
        own_pos = j * blk + jnp.arange(blk, dtype=jnp.int32)
        dist_own = (pos_q[:, None] - own_pos[None, :])
        sc_own = jnp.einsum('bhqd,bhkd->bhqk', qc, k_own) * scale - slope * jnp.abs(dist_own).astype(jnp.float32)
        sc_own = jnp.where(dist_own >= 0, sc_own, -jnp.inf)
        scores = jnp.concatenate([sc_sel.reshape(b_, h_, qc_n, k_eff * blk), sc_own], axis=-1)
        p = jax.nn.softmax(scores, axis=-1)
        p_sel = p[..., :k_eff * blk].reshape(b_, h_, qc_n, k_eff, blk)
        p_own = p[..., k_eff * blk:]
        return (jnp.einsum('bhqnk,bhqnkd->bhqd', p_sel, v_sel)
                + jnp.einsum('bhqk,bhkd->bhqd', p_own, v_own))

    out = lax.map(step, (q_chunks, jnp.arange(n_q, dtype=jnp.int32)))
    return out.transpose(1, 2, 0, 3, 4).reshape(b_, h_, s_, dh)


def hybrid_layer(x, c, w_ada, b_ada, g_norm, w_in, conv_w, conv_b, b_igate, b_fgate,
                 g_mlstm_head, w_out):
    b_, s_, _ = x.shape
    ada = jax.nn.silu(c.astype(jnp.float32)) @ w_ada.astype(jnp.float32) + b_ada.astype(jnp.float32)
    shift, scale, gate = jnp.split(ada, 3, axis=-1)
    h = rms_norm(x, g_norm) * (1.0 + scale[:, None]) + shift[:, None]
    proj = h @ w_in.astype(jnp.float32)
    (qm, km, vm, om, im, fm, zm, qb, kb, vb, zb) = jnp.split(
        proj, np.cumsum(SPLIT_SIZES)[:-1].tolist(), axis=-1)

    qk = jax.nn.silu(causal_short_conv(jnp.concatenate([qm, km], axis=-1), conv_w, conv_b))
    qm, km = jnp.split(qk, 2, axis=-1)
    i_pre = (im + b_igate.astype(jnp.float32)).transpose(0, 2, 1)
    f_pre = (fm + b_fgate.astype(jnp.float32)).transpose(0, 2, 1)
    hm = mlstm_chunkwise(to_heads(qm, N_HEADS_MLSTM), to_heads(km, N_HEADS_MLSTM),
                         to_heads(vm, N_HEADS_MLSTM), i_pre, f_pre)
    hm = hm * lax.rsqrt(jnp.mean(hm * hm, axis=-1, keepdims=True) + EPS)
    hm = hm.transpose(0, 2, 1, 3).reshape(b_, s_, D_MLSTM) * g_mlstm_head.astype(jnp.float32)
    out_a = hm * jax.nn.sigmoid(om) * jax.nn.silu(zm)

    hb = moba_attention(to_heads(qb, N_HEADS_MOBA), to_heads(kb, N_HEADS_MOBA),
                        to_heads(vb, N_HEADS_MOBA), alibi_slopes(N_HEADS_MOBA))
    out_b = hb.transpose(0, 2, 1, 3).reshape(b_, s_, D_MOBA) * jax.nn.silu(zb)

    y = jnp.concatenate([out_a, out_b], axis=-1) @ w_out.astype(jnp.float32)
    return x.astype(jnp.float32) + gate[:, None] * y


def setup_inputs(seed: int = 0) -> dict:
    key = jax.random.key(seed)
    ks = jax.random.split(key, 13)
    f32 = jnp.float32
    x = jax.random.normal(ks[0], (BATCH, SEQ, D_MODEL), f32)
    c = jax.random.normal(ks[1], (BATCH, D_MODEL), f32)
    w_ada = jax.random.normal(ks[2], (DEPTH, D_MODEL, 3 * D_MODEL), f32) * D_MODEL ** -0.5
    b_ada = 0.01 * jax.random.normal(ks[3], (DEPTH, 3 * D_MODEL), f32)
    g_norm = 1.0 + 0.02 * jax.random.normal(ks[4], (DEPTH, D_MODEL), f32)
    w_in = jax.random.normal(ks[5], (DEPTH, D_MODEL, PROJ_DIM), f32) * D_MODEL ** -0.5
    conv_w = jax.random.normal(ks[6], (DEPTH, CONV_K, 2 * D_MLSTM), f32) * CONV_K ** -0.5
    conv_b = 0.01 * jax.random.normal(ks[7], (DEPTH, 2 * D_MLSTM), f32)
    b_igate = 0.1 * jax.random.normal(ks[8], (DEPTH, N_HEADS_MLSTM), f32)
    b_fgate = (jnp.linspace(3.0, 6.0, N_HEADS_MLSTM, dtype=f32)[None, :]
               + 0.1 * jax.random.normal(ks[9], (DEPTH, N_HEADS_MLSTM), f32))
    g_mlstm_head = 1.0 + 0.02 * jax.random.normal(ks[10], (DEPTH, D_MLSTM), f32)
    w_out = jax.random.normal(ks[11], (DEPTH, D_MIX, D_MODEL), f32) * D_MIX ** -0.5
    g_final = 1.0 + 0.02 * jax.random.normal(ks[12], (D_MODEL,), f32)
    return {"x": x, "c": c, "w_ada": w_ada, "b_ada": b_ada, "g_norm": g_norm, "w_in": w_in,
            "conv_w": conv_w, "conv_b": conv_b, "b_igate": b_igate, "b_fgate": b_fgate,
            "g_mlstm_head": g_mlstm_head, "w_out": w_out, "g_final": g_final}


def reference(x, c, w_ada, b_ada, g_norm, w_in, conv_w, conv_b, b_igate, b_fgate,
              g_mlstm_head, w_out, g_final):
    h = x.astype(jnp.float32)
    for layer in range(DEPTH):
        h = hybrid_layer(h, c, w_ada[layer], b_ada[layer], g_norm[layer], w_in[layer],
                         conv_w[layer], conv_b[layer], b_igate[layer], b_fgate[layer],
                         g_mlstm_head[layer], w_out[layer])
    return rms_norm(h, g_final).astype(x.dtype)
```

```cpp
#include <hip/hip_runtime.h>
#include <stdint.h>

#define B_ 8
#define S_ 2048
#define D_ 1024
#define T_ (B_ * S_)
#define NP 4608
#define NPROJ 4616

#define OQM 0
#define OKM 512
#define OVM 1024
#define OOM 1536
#define OZM 2048
#define OQB 2560
#define OKB 3072
#define OVB 3584
#define OZB 4096

typedef unsigned short bf16_t;

__device__ __forceinline__ bf16_t f2bf(float f) {
  unsigned u = __float_as_uint(f);
  u += 0x7fffu + ((u >> 16) & 1u);
  return (bf16_t)(u >> 16);
}
__device__ __forceinline__ float bf2f(bf16_t h) { return __uint_as_float(((unsigned)h) << 16); }
__device__ __forceinline__ float siluf(float v) { return v / (1.0f + __expf(-v)); }
__device__ __forceinline__ float sigmoidf(float v) { return 1.0f / (1.0f + __expf(-v)); }

__device__ __forceinline__ int orig_col(int np) {
  if (np < 2048) return np;
  if (np < 4608) return np + 8;
  return 2048 + (np - 4608);
}

__global__ void __launch_bounds__(256) k_ada(const float* __restrict__ c, const float* __restrict__ w_ada,
                                             const float* __restrict__ b_ada, float* __restrict__ ada) {
  __shared__ float sc[1024];
  int b = blockIdx.y;
  int j = blockIdx.x * 256 + threadIdx.x;
  for (int k = threadIdx.x; k < 1024; k += 256) sc[k] = siluf(c[b * 1024 + k]);
  __syncthreads();
  float acc = 0.f;
  for (int k = 0; k < 1024; ++k) acc += sc[k] * w_ada[(size_t)k * 3072 + j];
  ada[b * 3072 + j] = acc + b_ada[j];
}

__global__ void __launch_bounds__(256) k_h(const float* __restrict__ x, const float* __restrict__ g,
                                           const float* __restrict__ ada, bf16_t* __restrict__ h) {
  __shared__ float red[4];
  int t = blockIdx.x;
  int b = t / S_;
  const float* xr = x + (size_t)t * D_;
  float v[4];
  float ss = 0.f;
  for (int i = 0; i < 4; ++i) { v[i] = xr[threadIdx.x + 256 * i]; ss += v[i] * v[i]; }
  for (int o = 32; o > 0; o >>= 1) ss += __shfl_xor(ss, o);
  if ((threadIdx.x & 63) == 0) red[threadIdx.x >> 6] = ss;
  __syncthreads();
  float tot = red[0] + red[1] + red[2] + red[3];
  float r = rsqrtf(tot * (1.0f / 1024.0f) + 1e-6f);
  for (int i = 0; i < 4; ++i) {
    int k = threadIdx.x + 256 * i;
    float hv = v[i] * r * g[k] * (1.0f + ada[b * 3072 + 1024 + k]) + ada[b * 3072 + k];
    h[(size_t)t * D_ + k] = f2bf(hv);
  }
}

template <int MODE>
__global__ void __launch_bounds__(256) k_gemm_naive(const bf16_t* __restrict__ A, const float* __restrict__ W,
                                                    bf16_t* __restrict__ Cb, float* __restrict__ Cf, int N, int ldw) {
  __shared__ float As[16][65];
  __shared__ float Bs[16][65];
  int tx = threadIdx.x & 15, ty = threadIdx.x >> 4;
  int m0 = blockIdx.y * 64, n0 = blockIdx.x * 64;
  float acc[4][4];
  for (int i = 0; i < 4; ++i) for (int j = 0; j < 4; ++j) acc[i][j] = 0.f;
  for (int k0 = 0; k0 < 1024; k0 += 16) {
    for (int e = threadIdx.x; e < 1024; e += 256) {
      int kk = e & 15, mm = e >> 4;
      As[kk][mm] = bf2f(A[(size_t)(m0 + mm) * 1024 + k0 + kk]);
      int nn = e & 63, k2 = e >> 6;
      int n = n0 + nn;
      float wv = 0.f;
      if (n < N) {
        int oc = (MODE == 0) ? orig_col(n) : n;
        wv = W[(size_t)(k0 + k2) * ldw + oc];
      }
      Bs[k2][nn] = wv;
    }
    __syncthreads();
    for (int kk = 0; kk < 16; ++kk) {
      float a[4], bb[4];
      for (int i = 0; i < 4; ++i) a[i] = As[kk][ty * 4 + i];
      for (int j = 0; j < 4; ++j) bb[j] = Bs[kk][tx * 4 + j];
      for (int i = 0; i < 4; ++i) for (int j = 0; j < 4; ++j) acc[i][j] += a[i] * bb[j];
    }
    __syncthreads();
  }
  for (int i = 0; i < 4; ++i) for (int j = 0; j < 4; ++j) {
    int m = m0 + ty * 4 + i, n = n0 + tx * 4 + j;
    if (n >= N) continue;
    if (MODE == 0) {
      if (n < NP) Cb[(size_t)m * NP + n] = f2bf(acc[i][j]);
      else Cf[(size_t)m * 8 + (n - NP)] = acc[i][j];
    } else {
      Cf[(size_t)m * 1024 + n] = acc[i][j];
    }
  }
}

__global__ void __launch_bounds__(256) k_conv(const bf16_t* __restrict__ proj, const float* __restrict__ conv_w,
                                              const float* __restrict__ conv_b, bf16_t* __restrict__ qkc) {
  int t = blockIdx.x;
  int s = t % S_;
  for (int ch = threadIdx.x; ch < 1024; ch += 256) {
    float acc = conv_b[ch];
    for (int tap = 0; tap < 4; ++tap) {
      int ss = s - 3 + tap;
      if (ss >= 0) acc += bf2f(proj[(size_t)(t - 3 + tap) * NP + ch]) * conv_w[tap * 1024 + ch];
    }
    float v = siluf(acc);
    if (ch >= 512) v *= 0.08838834764831845f;
    qkc[(size_t)t * 1024 + ch] = f2bf(v);
  }
}

__global__ void __launch_bounds__(256) k_cloc(const bf16_t* __restrict__ proj, const bf16_t* __restrict__ qkc,
                                              const float* __restrict__ gates, const float* __restrict__ b_i,
                                              const float* __restrict__ b_f, float* __restrict__ Cst,
                                              float* __restrict__ nst, float* __restrict__ amax, float* __restrict__ ftot) {
  __shared__ float logf_[64], cumf[64], a_[64], w_[64];
  __shared__ float ks[64][129];
  int bhc = blockIdx.x;
  int c = bhc & 31, h = (bhc >> 5) & 3, b = bhc >> 7;
  int t0 = b * S_ + c * 64;
  int tid = threadIdx.x;
  if (tid < 64) {
    float fp = gates[(size_t)(t0 + tid) * 8 + 4 + h] + b_f[h];
    float lf = (fp > 0.f) ? -log1pf(__expf(-fp)) : (fp - log1pf(__expf(fp)));
    logf_[tid] = lf;
  }
  for (int e = tid; e < 64 * 128; e += 256) {
    int s = e >> 7, k = e & 127;
    ks[s][k] = bf2f(qkc[(size_t)(t0 + s) * 1024 + 512 + h * 128 + k]);
  }
  __syncthreads();
  if (tid == 0) {
    float cs = 0.f;
    for (int s = 0; s < 64; ++s) { cs += logf_[s]; cumf[s] = cs; }
  }
  __syncthreads();
  if (tid < 64) {
    float ip = gates[(size_t)(t0 + tid) * 8 + h] + b_i[h];
    a_[tid] = cumf[63] - cumf[tid] + ip;
  }
  __syncthreads();
  if (tid == 0) {
    float m = a_[0];
    for (int s = 1; s < 64; ++s) m = fmaxf(m, a_[s]);
    amax[bhc] = m; ftot[bhc] = cumf[63];
    logf_[0] = m;
  }
  __syncthreads();
  if (tid < 64) w_[tid] = __expf(a_[tid] - logf_[0]);
  __syncthreads();
  int k = tid & 127;
  for (int v = (tid >> 7); v < 128; v += 2) {
    float acc = 0.f;
    for (int s = 0; s < 64; ++s) {
      float vv = bf2f(proj[(size_t)(t0 + s) * NP + OVM + h * 128 + v]);
      acc += w_[s] * vv * ks[s][k];
    }
    Cst[(size_t)bhc * 16384 + v * 128 + k] = acc;
  }
  if (tid < 128) {
    float acc = 0.f;
    for (int s = 0; s < 64; ++s) acc += w_[s] * ks[s][tid];
    nst[(size_t)bhc * 128 + tid] = acc;
  }
}

__global__ void __launch_bounds__(256) k_scan(float* __restrict__ Cst, float* __restrict__ nst,
                                              const float* __restrict__ amax, const float* __restrict__ ftot,
                                              float* __restrict__ mprev) {
  int bh = blockIdx.y;
  int e = blockIdx.x * 256 + threadIdx.x;
  if (e >= 16384 + 128) return;
  float st = 0.f, m = 0.f;
  for (int c = 0; c < 32; ++c) {
    int bhc = bh * 32 + c;
    float am = amax[bhc], ft = ftot[bhc];
    float mn = fmaxf(ft + m, am);
    float so = __expf(ft + m - mn), sn = __expf(am - mn);
    float* p = (e < 16384) ? (Cst + (size_t)bhc * 16384 + e) : (nst + (size_t)bhc * 128 + (e - 16384));
    float loc = *p;
    *p = st;
    if (e == 0) mprev[bhc] = m;
    st = so * st + sn * loc;
    m = mn;
  }
}

__global__ void __launch_bounds__(256) k_mout(const bf16_t* __restrict__ proj, const bf16_t* __restrict__ qkc,
                                              const float* __restrict__ gates, const float* __restrict__ b_i,
                                              const float* __restrict__ b_f, const float* __restrict__ Cst,
                                              const float* __restrict__ nst, const float* __restrict__ mprev,
                                              const float* __restrict__ g_head, bf16_t* __restrict__ mix) {
  __shared__ float logf_[64], cumf[64], logi[64], mt[64], isc[64], den[64], rn[64];
  __shared__ float Sm[64][65];
  __shared__ float hs[64][129];
  int bhc = blockIdx.x;
  int c = bhc & 31, h = (bhc >> 5) & 3, b = bhc >> 7;
  int t0 = b * S_ + c * 64;
  int tid = threadIdx.x;
  float mp = mprev[bhc];
  if (tid < 64) {
    float fp = gates[(size_t)(t0 + tid) * 8 + 4 + h] + b_f[h];
    float lf = (fp > 0.f) ? -log1pf(__expf(-fp)) : (fp - log1pf(__expf(fp)));
    logf_[tid] = lf;
    logi[tid] = gates[(size_t)(t0 + tid) * 8 + h] + b_i[h];
  }
  __syncthreads();
  if (tid == 0) {
    float cs = 0.f;
    for (int s = 0; s < 64; ++s) { cs += logf_[s]; cumf[s] = cs; }
  }
  __syncthreads();
  if (tid < 64) {
    int t = tid;
    float mi = cumf[t] + mp;
    float mx = -INFINITY;
    for (int s = 0; s <= t; ++s) mx = fmaxf(mx, cumf[t] - cumf[s] + logi[s]);
    float m = fmaxf(mi, mx);
    mt[t] = m;
    isc[t] = __expf(mi - m);
  }
  __syncthreads();
  const bf16_t* qb = qkc + (size_t)t0 * 1024 + h * 128;
  const bf16_t* kb = qkc + (size_t)t0 * 1024 + 512 + h * 128;
  for (int e = tid; e < 4096; e += 256) {
    int t = e >> 6, s = e & 63;
    float val = 0.f;
    if (s <= t) {
      float dot = 0.f;
      for (int k = 0; k < 128; ++k) dot += bf2f(qb[(size_t)t * 1024 + k]) * bf2f(kb[(size_t)s * 1024 + k]);
      val = dot * __expf(cumf[t] - cumf[s] + logi[s] - mt[t]);
    }
    Sm[t][s] = val;
  }
  __syncthreads();
  if (tid < 64) {
    int t = tid;
    float d = 0.f;
    for (int s = 0; s < 64; ++s) d += Sm[t][s];
    float nq = 0.f;
    for (int k = 0; k < 128; ++k) nq += nst[(size_t)bhc * 128 + k] * bf2f(qb[(size_t)t * 1024 + k]);
    d += isc[t] * nq;
    den[t] = fmaxf(fabsf(d), __expf(-mt[t]));
  }
  __syncthreads();
  for (int e = tid; e < 64 * 128; e += 256) {
    int t = e >> 7, v = e & 127;
    float acc = 0.f;
    for (int s = 0; s <= t; ++s) acc += Sm[t][s] * bf2f(proj[(size_t)(t0 + s) * NP + OVM + h * 128 + v]);
    float cq = 0.f;
    for (int k = 0; k < 128; ++k) cq += Cst[(size_t)bhc * 16384 + v * 128 + k] * bf2f(qb[(size_t)t * 1024 + k]);
    acc += isc[t] * cq;
    hs[t][v] = acc / den[t];
  }
  __syncthreads();
  if (tid < 64) {
    float ss = 0.f;
    for (int v = 0; v < 128; ++v) ss += hs[tid][v] * hs[tid][v];
    rn[tid] = rsqrtf(ss * (1.0f / 128.0f) + 1e-6f);
  }
  __syncthreads();
  for (int e = tid; e < 64 * 128; e += 256) {
    int t = e >> 7, v = e & 127;
    float hm = hs[t][v] * rn[t] * g_head[h * 128 + v];
    float om = bf2f(proj[(size_t)(t0 + t) * NP + OOM + h * 128 + v]);
    float zm = bf2f(proj[(size_t)(t0 + t) * NP + OZM + h * 128 + v]);
    mix[(size_t)(t0 + t) * 1024 + h * 128 + v] = f2bf(hm * sigmoidf(om) * siluf(zm));
  }
}

__global__ void __launch_bounds__(64) k_kmean(const bf16_t* __restrict__ proj, float* __restrict__ kmean) {
  int bhn = blockIdx.x;
  int n = bhn & 7, h = (bhn >> 3) & 7, b = bhn >> 6;
  int d = threadIdx.x;
  float acc = 0.f;
  for (int s = 0; s < 256; ++s) acc += bf2f(proj[(size_t)(b * S_ + n * 256 + s) * NP + OKB + h * 64 + d]);
  kmean[(size_t)bhn * 64 + d] = acc * (1.0f / 256.0f);
}

__global__ void __launch_bounds__(64) k_moba(const bf16_t* __restrict__ proj, const float* __restrict__ kmean,
                                             bf16_t* __restrict__ mix) {
  int t = blockIdx.x * 64 + threadIdx.x;
  int h = blockIdx.y;
  int b = t / S_, s = t % S_;
  int j = s >> 8;
  float slope = exp2f(-(float)(h + 1));
  float q[64], o[64];
#pragma unroll
  for (int d = 0; d < 64; ++d) { q[d] = bf2f(proj[(size_t)t * NP + OQB + h * 64 + d]); o[d] = 0.f; }
  unsigned selmask = 0;
  if (j <= 3) {
    selmask = (1u << j) - 1u;
  } else {
    float gv[8];
#pragma unroll
    for (int n = 0; n < 8; ++n) {
      float acc = 0.f;
      if (n < j) {
#pragma unroll
        for (int d = 0; d < 64; ++d) acc += q[d] * kmean[(size_t)((b * 8 + h) * 8 + n) * 64 + d];
      } else acc = -INFINITY;
      gv[n] = acc;
    }
    for (int r = 0; r < 3; ++r) {
      float best = -INFINITY; int bi = -1;
#pragma unroll
      for (int n = 0; n < 8; ++n) {
        bool ok = !((selmask >> n) & 1u) && (n < j);
        if (ok && (gv[n] > best || bi < 0)) { best = gv[n]; bi = n; }
      }
      selmask |= (1u << bi);
    }
  }
  float m = -INFINITY, l = 0.f;
  for (int n = 0; n <= j; ++n) {
    bool sel = (n == j) || ((selmask >> n) & 1u);
    if (!sel) continue;
    int kend = (n == j) ? (s - j * 256 + 1) : 256;
    for (int kk = 0; kk < kend; ++kk) {
      int pk = n * 256 + kk;
      const bf16_t* kr = proj + (size_t)(b * S_ + pk) * NP + OKB + h * 64;
      float dot = 0.f;
#pragma unroll
      for (int d = 0; d < 64; ++d) dot += q[d] * bf2f(kr[d]);
      float sc = dot * 0.125f - slope * (float)(s - pk);
      float mn = fmaxf(m, sc);
      float corr = __expf(m - mn);
      float p = __expf(sc - mn);
      l = l * corr + p;
      const bf16_t* vr = proj + (size_t)(b * S_ + pk) * NP + OVB + h * 64;
#pragma unroll
      for (int d = 0; d < 64; ++d) o[d] = o[d] * corr + p * bf2f(vr[d]);
      m = mn;
    }
  }
  float inv = 1.0f / l;
#pragma unroll
  for (int d = 0; d < 64; ++d) {
    float zb = bf2f(proj[(size_t)t * NP + OZB + h * 64 + d]);
    mix[(size_t)t * 1024 + 512 + h * 64 + d] = f2bf(o[d] * inv * siluf(zb));
  }
}

__global__ void __launch_bounds__(256) k_final(const float* __restrict__ x, const float* __restrict__ ada,
                                               const float* __restrict__ gf, float* __restrict__ out) {
  __shared__ float red[4];
  int t = blockIdx.x;
  int b = t / S_;
  float v[4];
  float ss = 0.f;
  for (int i = 0; i < 4; ++i) {
    int k = threadIdx.x + 256 * i;
    v[i] = x[(size_t)t * D_ + k] + ada[b * 3072 + 2048 + k] * out[(size_t)t * D_ + k];
    ss += v[i] * v[i];
  }
  for (int o = 32; o > 0; o >>= 1) ss += __shfl_xor(ss, o);
  if ((threadIdx.x & 63) == 0) red[threadIdx.x >> 6] = ss;
  __syncthreads();
  float tot = red[0] + red[1] + red[2] + red[3];
  float r = rsqrtf(tot * (1.0f / 1024.0f) + 1e-6f);
  for (int i = 0; i < 4; ++i) {
    int k = threadIdx.x + 256 * i;
    out[(size_t)t * D_ + k] = v[i] * r * gf[k];
  }
}

extern "C" void kernel_launch(void* const* d_in, const int* in_sizes, int n_in, void* d_out, int out_size,
                              void* d_ws, size_t ws_size, hipStream_t stream) {
  const float* x = (const float*)d_in[0];
  const float* c = (const float*)d_in[1];
  const float* w_ada = (const float*)d_in[2];
  const float* b_ada = (const float*)d_in[3];
  const float* g_norm = (const float*)d_in[4];
  const float* w_in = (const float*)d_in[5];
  const float* conv_w = (const float*)d_in[6];
  const float* conv_b = (const float*)d_in[7];
  const float* b_ig = (const float*)d_in[8];
  const float* b_fg = (const float*)d_in[9];
  const float* g_head = (const float*)d_in[10];
  const float* w_out = (const float*)d_in[11];
  const float* g_final = (const float*)d_in[12];
  float* out = (float*)d_out;

  char* ws = (char*)d_ws;
  size_t off = 0;
  auto carve = [&](size_t bytes) { char* p = ws + off; off += (bytes + 255) & ~(size_t)255; return p; };
  bf16_t* proj = (bf16_t*)carve((size_t)T_ * NP * 2);
  bf16_t* hbuf = (bf16_t*)carve((size_t)T_ * D_ * 2);
  bf16_t* mix = (bf16_t*)carve((size_t)T_ * D_ * 2);
  float* gates = (float*)carve((size_t)T_ * 8 * 4);
  float* ada = (float*)carve(8 * 3072 * 4);
  float* nst = (float*)carve(1024 * 128 * 4);
  float* amax = (float*)carve(1024 * 4);
  float* ftot = (float*)carve(1024 * 4);
  float* mprev = (float*)carve(1024 * 4);
  float* kmean = (float*)carve(8 * 8 * 8 * 64 * 4);
  float* Cst = (float*)d_out;
  bf16_t* qkc = hbuf;

  k_ada<<<dim3(12, 8), 256, 0, stream>>>(c, w_ada, b_ada, ada);
  k_h<<<T_, 256, 0, stream>>>(x, g_norm, ada, hbuf);
  k_gemm_naive<0><<<dim3((NPROJ + 63) / 64, T_ / 64), 256, 0, stream>>>(hbuf, w_in, proj, gates, NPROJ, NPROJ);
  k_conv<<<T_, 256, 0, stream>>>(proj, conv_w, conv_b, qkc);
  k_cloc<<<1024, 256, 0, stream>>>(proj, qkc, gates, b_ig, b_fg, Cst, nst, amax, ftot);
  k_scan<<<dim3((16384 + 128 + 255) / 256, 32), 256, 0, stream>>>(Cst, nst, amax, ftot, mprev);
  k_mout<<<1024, 256, 0, stream>>>(proj, qkc, gates, b_ig, b_fg, Cst, nst, mprev, g_head, mix);
  k_kmean<<<512, 64, 0, stream>>>(proj, kmean);
  k_moba<<<dim3(T_ / 64, 8), 64, 0, stream>>>(proj, kmean, mix);
  k_gemm_naive<1><<<dim3(1024 / 64, T_ / 64), 256, 0, stream>>>(mix, w_out, nullptr, out, 1024, 1024);
  k_final<<<T_, 256, 0, stream>>>(x, ada, g_final, out);
}
```

```cpp
#include <hip/hip_runtime.h>
#include <cstdio>
#include <cstdint>

#define B_ 8
#define S_ 2048
#define D_ 1024
#define T_ (B_ * S_)
#define NP 4608
#define NPROJ 4616
#define OQM 0
#define OKM 512
#define OVM 1024
#define OOM 1536
#define OZM 2048
#define OQB 2560
#define OKB 3072
#define OVB 3584
#define OZB 4096
#define NKS 16

typedef unsigned short bf16_t;
namespace pg8 {
#define PG8_LAS __attribute__((address_space(3)))
typedef unsigned short bf16_t;
typedef short bf16x8 __attribute__((ext_vector_type(8)));
typedef float f32x4 __attribute__((ext_vector_type(4)));
typedef unsigned u32x4 __attribute__((ext_vector_type(4)));
constexpr int BM = 256, BK = 64, HALF = 128, HTB = HALF * BK * 2  , STAGE_BYTES = 8 * HTB, NXCD = 8, WGM = 8;

__host__ __device__ __forceinline__ int lds_byte(int r, int c) { const int st = (r >> 4) * 2 + (c >> 5), rr = r & 15, cc = c & 31, ob = rr * 64 + cc * 2; return st * 1024 + (ob ^ (((ob >> 9) & 1) << 5)); }
__host__ __device__ __forceinline__ void stage_rc(int b, int& R, int& C) { const int st = b / 1024, sb = b % 1024, swz = sb ^ (((sb >> 9) & 1) << 5); R = (st >> 1) * 16 + swz / 64; C = (st & 1) * 32 + (swz % 64) / 2; }
__host__ __device__ __forceinline__ int perm32(int rho) { const int n = rho >> 4, i = rho & 15; return 8 * (i >> 2) + 4 * n + (i & 3); }

struct Unit { int pm, pn; };
struct Gemm { const bf16_t* A; const bf16_t* Bt; int M, N, K; };

struct StaticOrder {
    int nM, nN, nwg, G, c;
    __host__ __device__ void init(int M, int N, int G_, int c_) { nM = M / BM; nN = N / BM; nwg = nM * nN; G = G_; c = c_; }
    __host__ __device__ bool next(int i, Unit& u) const {
        const long L = (long)i * G + c; if (L >= nwg) return false;
        int wgid = (int)L; { const int q = nwg / NXCD, r = nwg % NXCD, xcd = wgid % NXCD, off = wgid / NXCD; wgid = (xcd < r ? xcd * (q + 1) : r * (q + 1) + (xcd - r) * q) + off; }
        const int nig = WGM * nN, gid = wgid / nig, fm = gid * WGM, gsz = (nM - fm) < WGM ? (nM - fm) : WGM;
        u.pm = fm + ((wgid % nig) % gsz); u.pn = (wgid % nig) / gsz; return true;
    }
    __device__ __forceinline__ void a_ready(const Unit&) const {}
    __device__ __forceinline__ void done(const Unit&) const {}
};

__device__ __forceinline__ unsigned cvt_pk_bf16(float lo, float hi) { unsigned r; asm volatile("v_cvt_pk_bf16_f32 %0, %1, %2" : "=v"(r) : "v"(lo), "v"(hi)); return r; }

struct EpiProj {
    static constexpr bool PERM = true, AFTER_DRAIN = false;
    bf16_t* O; int ldc; int qt_lo, qt_hi; float qscale;
    __device__ __forceinline__ void operator()(const f32x4 (&acc)[2][2][4][2], const Unit& u, int wr, int wc, int fr, int fq) const {
        const int row0 = u.pm * BM + wr * 64 + fr; const int col0 = u.pn * BM + wc * 32 + 8 * fq;
        const float sc = (u.pn >= qt_lo && u.pn < qt_hi) ? qscale : 1.f;
#pragma unroll
        for (int ai = 0; ai < 2; ++ai)
#pragma unroll
            for (int m = 0; m < 4; ++m) { bf16_t* rowp = O + (size_t)(row0 + ai * HALF + m * 16) * ldc + col0;
#pragma unroll
                for (int bj = 0; bj < 2; ++bj) { f32x4 v0 = acc[ai][bj][m][0] * sc, v1 = acc[ai][bj][m][1] * sc;
                    u32x4 w; w.x = cvt_pk_bf16(v0[0], v0[1]); w.y = cvt_pk_bf16(v0[2], v0[3]); w.z = cvt_pk_bf16(v1[0], v1[1]); w.w = cvt_pk_bf16(v1[2], v1[3]);
                    *(u32x4*)(rowp + bj * HALF) = w; } }
    }
};
struct EpiOut {
    static constexpr bool PERM = false, AFTER_DRAIN = false;
    const float* X; const float* gate; float* XN; float* rowss;
    __device__ __forceinline__ void operator()(const f32x4 (&acc)[2][2][4][2], const Unit& u, int wr, int wc, int fr, int fq) const {
        const int row0 = u.pm * BM + wr * 64 + fr, col0 = u.pn * BM + wc * 32 + 4 * fq;
        const float* gb = gate + (size_t)((u.pm * BM) / 2048) * 3072 + 2048;
        f32x4 gv[2][2];
#pragma unroll
        for (int bj = 0; bj < 2; ++bj)
#pragma unroll
            for (int n = 0; n < 2; ++n) gv[bj][n] = *(const f32x4*)(gb + col0 + bj * HALF + n * 16);
#pragma unroll
        for (int ai = 0; ai < 2; ++ai)
#pragma unroll
            for (int m = 0; m < 4; ++m) { const size_t ro = (size_t)(row0 + ai * HALF + m * 16) * 1024 + col0; float ss = 0.f;
#pragma unroll
                for (int bj = 0; bj < 2; ++bj)
#pragma unroll
                    for (int n = 0; n < 2; ++n) { const f32x4 xv = *(const f32x4*)(X + ro + bj * HALF + n * 16); const f32x4 r = xv + gv[bj][n] * acc[ai][bj][m][n];
                        ss += r[0] * r[0] + r[1] * r[1] + r[2] * r[2] + r[3] * r[3]; *(f32x4*)(XN + ro + bj * HALF + n * 16) = r; }
                ss += __shfl_xor(ss, 16); ss += __shfl_xor(ss, 32);
                if (fq == 0) rowss[((size_t)(row0 + ai * HALF + m * 16) * 4 + u.pn) * 4 + wc] = ss; }
    }
};
template <class Epi, class Sched, bool ALIGN_EPI = false, bool SP2 = false>
__device__ __forceinline__ void gemm_phase(PG8_LAS unsigned char* lds, const Gemm g, const Sched& S, const Epi& E) {
    const int tid = threadIdx.x, wid = __builtin_amdgcn_readfirstlane(tid >> 6), lane = tid & 63, wr = wid >> 2, wc = wid & 3, fr = lane & 15, fq = lane >> 4;
    const int K = g.K, nt = K / BK;
    unsigned voffA[2], voffB[2];
#pragma unroll
    for (int i = 0; i < 2; ++i) { int R, C; stage_rc(tid * 16 + i * 8192, R, C); const int Rb = Epi::PERM ? ((R & ~31) + perm32(R & 31)) : R;
        voffA[i] = (unsigned)(R * K + C) * 2u; voffB[i] = (unsigned)(Rb * K + C) * 2u; }
    const size_t kstep = (size_t)(BK * 2);
    const size_t hstep = (size_t)HALF * K * 2;
    const size_t tstep = 2 * hstep;
    const unsigned ldsw = (unsigned)wid * 1024u;
    const int aoff = lds_byte(wr * 64 + fr, fq * 8), boff = lds_byte(wc * 32 + fr, fq * 8);
#define PG8_SA(b, h) (((b) * 2 + (h)) * HTB)
#define PG8_SB(b, h) ((4 + (b) * 2 + (h)) * HTB)
#define PG8_STAGE(bufoff, gbase, voff) do { _Pragma("unroll") for (int _i = 0; _i < 2; ++_i) \
        __builtin_amdgcn_global_load_lds((const unsigned*)((const char*)(gbase) + (voff)[_i]), (PG8_LAS unsigned*)(lds + (bufoff) + ldsw + _i * 8192), 16, 0, 0); } while (0)
#define PG8_LDA(dst, b, h) do { _Pragma("unroll") for (int m = 0; m < 4; ++m) _Pragma("unroll") for (int k = 0; k < 2; ++k) dst[m][k] = *(const PG8_LAS bf16x8*)(lds + PG8_SA(b, h) + aoff + m * 2048 + k * 1024); } while (0)
#define PG8_LDB(dst, b, h) do { _Pragma("unroll") for (int n = 0; n < 2; ++n) _Pragma("unroll") for (int k = 0; k < 2; ++k) dst[n][k] = *(const PG8_LAS bf16x8*)(lds + PG8_SB(b, h) + boff + n * 2048 + k * 1024); } while (0)
#define PG8_MMA(ai, bj, At, Bt) do { __builtin_amdgcn_s_setprio(1); _Pragma("unroll") for (int m = 0; m < 4; ++m) _Pragma("unroll") for (int n = 0; n < 2; ++n) _Pragma("unroll") for (int k = 0; k < 2; ++k) \
        acc[ai][bj][m][n] = __builtin_amdgcn_mfma_f32_16x16x32_bf16(Bt[n][k], At[m][k], acc[ai][bj][m][n], 0, 0, 0); __builtin_amdgcn_s_setprio(0); } while (0)
#define PG8_WAIT_V(n) asm volatile("s_waitcnt vmcnt(" #n ")" ::: "memory")
#define PG8_WAIT_L(n) asm volatile("s_waitcnt lgkmcnt(" #n ")" ::: "memory")
#define PG8_BAR __builtin_amdgcn_s_barrier()
#define PG8_SCHED __builtin_amdgcn_sched_barrier(0)
    Unit cur, nxt; int ui = 0;
    if (!S.next(0, cur)) return;
    f32x4 acc[2][2][4][2];
#pragma unroll
    for (int a = 0; a < 2; ++a)
#pragma unroll
        for (int b = 0; b < 2; ++b)
#pragma unroll
            for (int m = 0; m < 4; ++m)
#pragma unroll
                for (int n = 0; n < 2; ++n) acc[a][b][m][n] = (f32x4){0.f, 0.f, 0.f, 0.f};
    bf16x8 At[4][2], B0[2][2], B1[2][2];
    const char* cA = (const char*)g.A + (size_t)cur.pm * tstep; const char* cB = (const char*)g.Bt + (size_t)cur.pn * tstep;
    S.a_ready(cur);
    if constexpr (SP2) {
        PG8_STAGE(PG8_SB(0, 0), cB, voffB); PG8_STAGE(PG8_SB(0, 1), cB + hstep, voffB); PG8_STAGE(PG8_SA(0, 0), cA, voffA); PG8_STAGE(PG8_SA(0, 1), cA + hstep, voffA);
        if (wr == 1) PG8_BAR;
        PG8_WAIT_V(2); PG8_BAR;
        PG8_STAGE(PG8_SB(1, 0), cB + kstep, voffB); PG8_STAGE(PG8_SA(1, 0), cA + kstep, voffA); PG8_STAGE(PG8_SB(1, 1), cB + hstep + kstep, voffB);
        PG8_WAIT_V(6); PG8_BAR;
    } else {
        PG8_STAGE(PG8_SB(0, 0), cB, voffB); PG8_STAGE(PG8_SA(0, 0), cA, voffA); PG8_STAGE(PG8_SB(0, 1), cB + hstep, voffB); PG8_STAGE(PG8_SA(0, 1), cA + hstep, voffA);
        if (wr == 1) PG8_BAR;
        PG8_WAIT_V(4); PG8_BAR;
        PG8_STAGE(PG8_SB(1, 0), cB + kstep, voffB); PG8_STAGE(PG8_SA(1, 0), cA + kstep, voffA); PG8_STAGE(PG8_SB(1, 1), cB + hstep + kstep, voffB);
        PG8_WAIT_V(6); PG8_BAR;
    }
    for (;;) {
        const bool has_next = S.next(ui + 1, nxt);
        const char* nA = has_next ? (const char*)g.A + (size_t)nxt.pm * tstep : cA; const char* nB = has_next ? (const char*)g.Bt + (size_t)nxt.pn * tstep : cB;
        for (int t = 0; t < nt; t += 2) {
            const bool last = (t == nt - 2);
            const char* a1 = cA + (size_t)(t + 1) * kstep;
            const char* a2 = last ? nA : cA + (size_t)(t + 2) * kstep; const char* b2 = last ? nB : cB + (size_t)(t + 2) * kstep;
            const char* a3 = a2 + kstep; const char* b3 = b2 + kstep;
            if (last && has_next) S.a_ready(nxt);
            if constexpr (SP2) {
            PG8_LDB(B0, 0, 0); PG8_LDB(B1, 0, 1); PG8_SCHED; PG8_LDA(At, 0, 0); PG8_STAGE(PG8_SA(1, 1), a1 + hstep, voffA);
            PG8_WAIT_V(8); PG8_WAIT_L(0); PG8_BAR; PG8_MMA(0, 0, At, B0); PG8_MMA(0, 1, At, B1); PG8_BAR; PG8_SCHED;
            PG8_LDA(At, 0, 1); PG8_STAGE(PG8_SB(0, 0), b2, voffB); PG8_STAGE(PG8_SB(0, 1), b2 + hstep, voffB); PG8_STAGE(PG8_SA(0, 0), a2, voffA);
            PG8_WAIT_V(8); PG8_WAIT_L(0); PG8_BAR; PG8_MMA(1, 0, At, B0); PG8_MMA(1, 1, At, B1); PG8_BAR; PG8_SCHED;
            PG8_LDB(B0, 1, 0); PG8_LDB(B1, 1, 1); PG8_SCHED; PG8_LDA(At, 1, 0); PG8_STAGE(PG8_SA(0, 1), a2 + hstep, voffA);
            PG8_WAIT_V(8); PG8_WAIT_L(0); PG8_BAR; PG8_MMA(0, 0, At, B0); PG8_MMA(0, 1, At, B1); PG8_BAR; PG8_SCHED;
            PG8_LDA(At, 1, 1); PG8_STAGE(PG8_SB(1, 0), b3, voffB); PG8_STAGE(PG8_SB(1, 1), b3 + hstep, voffB); PG8_STAGE(PG8_SA(1, 0), a3, voffA);
            PG8_WAIT_V(8); PG8_WAIT_L(0); PG8_BAR; PG8_MMA(1, 0, At, B0); PG8_MMA(1, 1, At, B1); PG8_BAR; PG8_SCHED;
            } else {
            PG8_LDB(B0, 0, 0); PG8_SCHED; PG8_LDA(At, 0, 0); PG8_STAGE(PG8_SA(1, 1), a1 + hstep, voffA);
            PG8_WAIT_L(8); PG8_BAR; PG8_WAIT_L(0); PG8_MMA(0, 0, At, B0); PG8_BAR; PG8_SCHED;
            PG8_LDB(B1, 0, 1); PG8_STAGE(PG8_SB(0, 0), b2, voffB);
            PG8_BAR; PG8_WAIT_L(0); PG8_MMA(0, 1, At, B1); PG8_BAR;
            PG8_LDA(At, 0, 1); PG8_STAGE(PG8_SA(0, 0), a2, voffA);
            PG8_BAR; PG8_WAIT_L(0); PG8_MMA(1, 0, At, B0); PG8_BAR; PG8_SCHED;
            PG8_STAGE(PG8_SB(0, 1), b2 + hstep, voffB);
            PG8_WAIT_V(6); PG8_BAR; PG8_MMA(1, 1, At, B1); PG8_BAR;
            PG8_LDB(B0, 1, 0); PG8_SCHED; PG8_LDA(At, 1, 0); PG8_STAGE(PG8_SA(0, 1), a2 + hstep, voffA);
            PG8_WAIT_L(8); PG8_BAR; PG8_WAIT_L(0); PG8_MMA(0, 0, At, B0); PG8_BAR; PG8_SCHED;
            PG8_LDB(B1, 1, 1); PG8_STAGE(PG8_SB(1, 0), b3, voffB);
            PG8_BAR; PG8_WAIT_L(0); PG8_MMA(0, 1, At, B1); PG8_BAR;
            PG8_LDA(At, 1, 1); PG8_STAGE(PG8_SA(1, 0), a3, voffA);
            PG8_BAR; PG8_WAIT_L(0); PG8_MMA(1, 0, At, B0); PG8_BAR; PG8_SCHED;
            PG8_STAGE(PG8_SB(1, 1), b3 + hstep, voffB);
            PG8_WAIT_V(6); PG8_BAR; PG8_MMA(1, 1, At, B1); PG8_BAR;
            }
        }
        if constexpr (ALIGN_EPI) { if (wr == 0) PG8_BAR; }
        if constexpr (!Epi::AFTER_DRAIN) { E(acc, cur, wr, wc, fr, fq); S.done(cur); }
        if (!has_next) break;
#pragma unroll
        for (int a = 0; a < 2; ++a)
#pragma unroll
            for (int b = 0; b < 2; ++b)
#pragma unroll
                for (int m = 0; m < 4; ++m)
#pragma unroll
                    for (int n = 0; n < 2; ++n) acc[a][b][m][n] = (f32x4){0.f, 0.f, 0.f, 0.f};
        cur = nxt; cA = nA; cB = nB; ++ui;
        if constexpr (ALIGN_EPI) { if (wr == 1) PG8_BAR; }
    }
    PG8_WAIT_V(0);
    if constexpr (!ALIGN_EPI) { if (wr == 0) PG8_BAR; }
    PG8_BAR;
    if constexpr (Epi::AFTER_DRAIN) { E.fused(acc, cur, wr, wc, fr, fq, lds, wid, lane); S.done(cur); }
#undef PG8_SA
#undef PG8_SB
#undef PG8_STAGE
#undef PG8_LDA
#undef PG8_LDB
#undef PG8_MMA
#undef PG8_WAIT_V
#undef PG8_WAIT_L
#undef PG8_BAR
#undef PG8_SCHED
}
}

constexpr int NWAVES = 8;
constexpr size_t MiB = 1u << 20;
constexpr size_t WS_CTL = 0, CTL_ZERO_BYTES = 1 * MiB;
constexpr size_t WS_WTIN = 1 * MiB;
constexpr size_t WS_WTOUT = 10 * MiB;
constexpr size_t WS_ADAP = 12 * MiB;
constexpr size_t WS_ADA = 14 * MiB;
constexpr size_t WS_KMEAN = 14 * MiB + 128 * 1024;
constexpr size_t WS_GATES = 14 * MiB + 512 * 1024;
constexpr size_t WS_ROWSS = 15 * MiB;
constexpr size_t WS_MST = 16 * MiB;
constexpr size_t WS_H = 32 * MiB;
constexpr size_t WS_PROJ = 64 * MiB;
constexpr size_t WS_QKC = 208 * MiB;
constexpr size_t WS_SMALL = 240 * MiB;
constexpr size_t WS_END = 256 * MiB;
constexpr int CW_BAR = 4096;

constexpr int RING_BYTES = 131072;
constexpr int LDSCTL_OFF = RING_BYTES, MISC_OFF = LDSCTL_OFF + 320;
constexpr int LDS_BYTES = 147456;

#define GAS __attribute__((address_space(1)))
#define LAS __attribute__((address_space(3)))
typedef unsigned v4u __attribute__((ext_vector_type(4)));
typedef float f32x4 __attribute__((ext_vector_type(4)));
typedef short bf16x8 __attribute__((ext_vector_type(8)));
#define LDS_WAIT() asm volatile("s_waitcnt lgkmcnt(0)" ::: "memory")
#define VM_WAIT() asm volatile("s_waitcnt vmcnt(0)" ::: "memory")
__device__ __forceinline__ unsigned f2bf(float f) { unsigned u = __builtin_bit_cast(unsigned, f); return (u + 0x7fffu + ((u >> 16) & 1u)) >> 16; }
__device__ __forceinline__ unsigned pk2(float lo, float hi) { return f2bf(lo) | (f2bf(hi) << 16); }
__device__ __forceinline__ float bf2f(bf16_t h) { return __uint_as_float(((unsigned)h) << 16); }
__device__ __forceinline__ float siluf(float v) { return v / (1.0f + __expf(-v)); }
__device__ __forceinline__ float sigmoidf_(float v) { return 1.0f / (1.0f + __expf(-v)); }
__device__ __forceinline__ int orig_col(int np) { return np < 2048 ? np : np + 8; }

#define XB_TMO      128
#define XB_XCNT(j)  (256  + 64 * (j))
#define XB_XSUB(j)  (1280 + 64 * (j))
#define XB_XGEN(j)  (2304 + 64 * (j))
#define XB_TOP      3328
#define XB_TOPGEN   3392
#define XCD_BAR_WORDS 3456
#define XB_SPIN_CAP (1u << 18)
__device__ __forceinline__ unsigned xb_ld(unsigned* p)              { return __hip_atomic_load(p, __ATOMIC_RELAXED, __HIP_MEMORY_SCOPE_AGENT); }
__device__ __forceinline__ unsigned xb_add(unsigned* p, unsigned v) { return __hip_atomic_fetch_add(p, v, __ATOMIC_RELAXED, __HIP_MEMORY_SCOPE_AGENT); }
__device__ __forceinline__ unsigned xb_xcc_id() { return (unsigned)__builtin_amdgcn_s_getreg((3 << 11) | 20) & 0xFu; }
#define XB_SPIN(cond, bar) do { unsigned _sp = 0; while (cond) { __builtin_amdgcn_s_sleep(1); \
    if ((++_sp & 255u) == 0u) { if (xb_ld(&(bar)[XB_TMO])) break; if (_sp > XB_SPIN_CAP) { atomicAdd(&(bar)[XB_TMO], 1u); break; } } } } while (0)
struct XcdBarrier { unsigned* bar; unsigned x; volatile LAS unsigned* st; };
__device__ __forceinline__ XcdBarrier xcd_barrier_post(unsigned* bar, volatile LAS unsigned* st) {
    XcdBarrier b; b.bar = bar; b.x = xb_xcc_id(); b.st = st;
    if (threadIdx.x == 0) (void)xb_add(&bar[XB_XCNT(b.x)], 1u);
    return b;
}
__device__ __forceinline__ void xcd_barrier_complete(unsigned* bar, unsigned x, unsigned& nloc, unsigned& nx) {
    const unsigned G = gridDim.x * gridDim.y * gridDim.z;
    unsigned sum, cnt, mine, sp = 0u;
    for (;;) {
        sum = 0u; cnt = 0u; mine = 0u;
#pragma unroll
        for (unsigned j = 0; j < 16; ++j) { const unsigned c = xb_ld(&bar[XB_XCNT(j)]); sum += c; cnt += (c > 0u) ? 1u : 0u; mine = (j == x) ? c : mine; }
        if (sum == G) break;
        __builtin_amdgcn_s_sleep(1);
        if ((++sp & 255u) == 0u) { if (xb_ld(&bar[XB_TMO])) break; if (sp > XB_SPIN_CAP) { atomicAdd(&bar[XB_TMO], 1u); break; } }
    }
    nloc = mine > 0u ? mine : 1u; nx = cnt > 0u ? cnt : 1u;
}
__device__ __forceinline__ void xcd_barrier(const XcdBarrier& b) {
    asm volatile("s_waitcnt vmcnt(0)" ::: "memory");
    __syncthreads();
    if (threadIdx.x == 0) {
        unsigned* bar = b.bar;
        __builtin_amdgcn_s_waitcnt(0);
        unsigned nloc = b.st[0], nx = b.st[1];
        if (nloc == 0u) { xcd_barrier_complete(bar, b.x, nloc, nx); b.st[0] = nloc; b.st[1] = nx; }
        const unsigned old = xb_add(&bar[XB_XSUB(b.x)], 1u);
        const unsigned gen = old / nloc;
        if (old + 1u == (gen + 1u) * nloc) {
            __builtin_amdgcn_fence(__ATOMIC_RELEASE, "agent");
            asm volatile("s_waitcnt vmcnt(0)" ::: "memory");
            const unsigned og = xb_add(&bar[XB_TOP], 1u);
            const unsigned tg = og / nx;
            if (og + 1u == (tg + 1u) * nx) xb_add(&bar[XB_TOPGEN], 1u);
            else XB_SPIN(xb_ld(&bar[XB_TOPGEN]) == tg, bar);
            __builtin_amdgcn_fence(__ATOMIC_ACQUIRE, "agent");
            xb_add(&bar[XB_XGEN(b.x)], 1u);
            asm volatile("s_waitcnt vmcnt(0)" ::: "memory");
        } else {
            XB_SPIN(xb_ld(&bar[XB_XGEN(b.x)]) == gen, bar);
            __builtin_amdgcn_fence(__ATOMIC_ACQUIRE, "agent");
            asm volatile("s_waitcnt vmcnt(0)" ::: "memory");
        }
    }
    __syncthreads();
}

struct Frame {
    LAS unsigned char* lds;
    volatile LAS unsigned* MISC;
    int tid, lane, wave, vcu, G;
    const float *x, *c, *w_ada, *b_ada, *g_norm, *w_in, *conv_w, *conv_b, *b_ig, *b_fg, *g_head, *w_out, *g_final;
    float* out;
    unsigned char* ws;
};
__device__ __forceinline__ float wave_sum(float v) {
#pragma unroll
    for (int o = 1; o < 64; o <<= 1) v += __shfl_xor(v, o);
    return v;
}

__device__ __forceinline__ void p0_transpose_item(const float* W, int ldw, bool remap, bf16_t* WT, LAS float* scr, int kb, int nb, int lane) {
    const int k0 = 64 * kb, n0 = 32 * nb; const int c0 = remap ? orig_col(n0) : n0;
#pragma unroll 8
    for (int i = 0; i < 32; ++i) { const int kk = 2 * i + (lane >> 5); scr[kk * 33 + (lane & 31)] = W[(size_t)(k0 + kk) * ldw + c0 + (lane & 31)]; }
    LDS_WAIT(); asm volatile("" ::: "memory");
    const int c = lane & 7;
#pragma unroll
    for (int j = 0; j < 4; ++j) { const int n = (lane >> 3) + 8 * j; const LAS float* s = scr + (8 * c) * 33 + n;
        v4u o; o.x = pk2(s[0 * 33], s[1 * 33]); o.y = pk2(s[2 * 33], s[3 * 33]); o.z = pk2(s[4 * 33], s[5 * 33]); o.w = pk2(s[6 * 33], s[7 * 33]);
        *(GAS v4u*)(WT + (size_t)(n0 + n) * 1024 + k0 + 8 * c) = o; }
    LDS_WAIT(); asm volatile("" ::: "memory");
}
__device__ __forceinline__ void p0_prologue(Frame& F) {
    LAS float* scr = (LAS float*)(F.lds + F.wave * 8448);
    LAS float* sc = (LAS float*)(F.lds + 69632);
    for (int e = F.tid; e < 8192; e += NWAVES * 64) { const int b = e >> 10, k = e & 1023; sc[k * 8 + b] = siluf(F.c[e]); }
    __syncthreads();
    const int gw = F.vcu * NWAVES + F.wave, NGW = F.G * NWAVES;
    constexpr int I_ADA = 48 * NKS, I_IN = 16 * (NP / 32), I_OUT = 16 * 32;
    float* adaP = (float*)(F.ws + WS_ADAP);
    bf16_t* WtIn = (bf16_t*)(F.ws + WS_WTIN); bf16_t* WtOut = (bf16_t*)(F.ws + WS_WTOUT);
    for (int it = gw; it < I_ADA + I_IN + I_OUT; it += NGW) {
        int r = it;
        if (r < I_ADA) {
            const int cg = r % 48, ks = r / 48, j = cg * 64 + F.lane;
            float acc[8];
#pragma unroll
            for (int b = 0; b < 8; ++b) acc[b] = 0.f;
            const float* wp = F.w_ada + (size_t)(ks * 64) * 3072 + j;
#pragma unroll 4
            for (int k = 0; k < 64; ++k) { const float w = wp[(size_t)k * 3072];
                const f32x4 s0 = *(const LAS f32x4*)(sc + (ks * 64 + k) * 8), s1 = *(const LAS f32x4*)(sc + (ks * 64 + k) * 8 + 4);
                acc[0] += s0[0] * w; acc[1] += s0[1] * w; acc[2] += s0[2] * w; acc[3] += s0[3] * w;
                acc[4] += s1[0] * w; acc[5] += s1[1] * w; acc[6] += s1[2] * w; acc[7] += s1[3] * w; }
#pragma unroll
            for (int b = 0; b < 8; ++b) adaP[((size_t)ks * 8 + b) * 3072 + j] = acc[b];
            continue;
        }
        r -= I_ADA;
        if (r < I_IN) { p0_transpose_item(F.w_in, NPROJ, true, WtIn, scr, r / (NP / 32), r % (NP / 32), F.lane); continue; }
        r -= I_IN;
        p0_transpose_item(F.w_out, 1024, false, WtOut, scr, r / 32, r % 32, F.lane);
    }
}

__device__ __forceinline__ void p1_norm(Frame& F) {
    LAS float* gs = (LAS float*)(F.lds); LAS float* sh = gs + 1024;
    const float* adaP = (const float*)(F.ws + WS_ADAP);
    float* ada = (float*)(F.ws + WS_ADA);
    if (true) { for (int e = blockIdx.x * (NWAVES * 64) + F.tid; e < 8 * 3072; e += F.G * NWAVES * 64) { float v = F.b_ada[e % 3072];
#pragma unroll
        for (int s = 0; s < NKS; ++s) v += adaP[(size_t)s * 8 * 3072 + e];
        ada[e] = v; } }
    bf16_t* H = (bf16_t*)(F.ws + WS_H); float* gates = (float*)(F.ws + WS_GATES);
    f32x4 wg[4][4][2];
#pragma unroll
    for (int j = 0; j < 4; ++j)
#pragma unroll
        for (int i = 0; i < 4; ++i) { const float* wp = F.w_in + (size_t)(4 * F.lane + 256 * j + i) * NPROJ + 2048; wg[j][i][0] = *(const f32x4*)wp; wg[j][i][1] = *(const f32x4*)(wp + 4); }
    for (int rb = F.vcu; rb < T_ / 64; rb += F.G) {
        const int r0 = 64 * rb, b = r0 / S_;
        for (int k = F.tid; k < 1024; k += NWAVES * 64) {
            float scl = F.b_ada[1024 + k], sft = F.b_ada[k];
#pragma unroll
            for (int s = 0; s < NKS; ++s) { scl += adaP[((size_t)s * 8 + b) * 3072 + 1024 + k]; sft += adaP[((size_t)s * 8 + b) * 3072 + k]; }
            gs[k] = F.g_norm[k] * (1.0f + scl); sh[k] = sft;
        }
        __syncthreads();
        f32x4 gsv[4], shv[4];
#pragma unroll
        for (int j = 0; j < 4; ++j) { gsv[j] = *(const LAS f32x4*)(gs + 4 * F.lane + 256 * j); shv[j] = *(const LAS f32x4*)(sh + 4 * F.lane + 256 * j); }
        for (int rr = 0; rr < 8; ++rr) {
            const int m = r0 + F.wave * 8 + rr;
            const GAS f32x4* xr = (const GAS f32x4*)(F.x + (size_t)m * D_) + F.lane;
            f32x4 v[4]; float s = 0.f;
#pragma unroll
            for (int j = 0; j < 4; ++j) { v[j] = xr[64 * j]; s += (v[j].x * v[j].x + v[j].y * v[j].y) + (v[j].z * v[j].z + v[j].w * v[j].w); }
            const float rstd = rsqrtf(wave_sum(s) * (1.f / D_) + 1e-6f);
            float ga[8];
#pragma unroll
            for (int c = 0; c < 8; ++c) ga[c] = 0.f;
            GAS unsigned long long* o8 = (GAS unsigned long long*)(H + (size_t)m * D_) + F.lane;
#pragma unroll
            for (int j = 0; j < 4; ++j) {
                f32x4 hv = v[j] * rstd * gsv[j] + shv[j];
                o8[64 * j] = (unsigned long long)pk2(hv.x, hv.y) | ((unsigned long long)pk2(hv.z, hv.w) << 32);
#pragma unroll
                for (int i = 0; i < 4; ++i)
#pragma unroll
                    for (int c = 0; c < 8; ++c) ga[c] += hv[i] * wg[j][i][c >> 2][c & 3];
            }
#pragma unroll
            for (int c = 0; c < 8; ++c) ga[c] = wave_sum(ga[c]);
            if (F.lane == 0) { *(f32x4*)(gates + (size_t)m * 8) = (f32x4){ga[0], ga[1], ga[2], ga[3]}; *(f32x4*)(gates + (size_t)m * 8 + 4) = (f32x4){ga[4], ga[5], ga[6], ga[7]}; }
        }
        __syncthreads();
    }
}

constexpr float QSCALE = 0.125f * 1.4426950408889634f;

struct Args { const float* in[13]; float* out; unsigned char* ws; int ph_lo, ph_hi; };
__global__ void __launch_bounds__(NWAVES * 64, 2) mk_fwd(Args args) {
    extern __shared__ __attribute__((aligned(16))) unsigned char lds[];
    Frame F;
    F.lds = (LAS unsigned char*)lds;
    F.MISC = (volatile LAS unsigned*)(F.lds + MISC_OFF);
    F.tid = threadIdx.x; F.lane = F.tid & 63; F.wave = __builtin_amdgcn_readfirstlane(F.tid >> 6);
    F.G = gridDim.x; { const int bx = blockIdx.x; F.vcu = (F.G % 8 == 0) ? (bx % 8) * (F.G / 8) + bx / 8 : bx; }
    F.x = args.in[0]; F.c = args.in[1]; F.w_ada = args.in[2]; F.b_ada = args.in[3]; F.g_norm = args.in[4]; F.w_in = args.in[5];
    F.conv_w = args.in[6]; F.conv_b = args.in[7]; F.b_ig = args.in[8]; F.b_fg = args.in[9]; F.g_head = args.in[10]; F.w_out = args.in[11]; F.g_final = args.in[12];
    F.out = args.out; F.ws = args.ws;
    for (int u = F.tid; u < (LDS_BYTES - LDSCTL_OFF) / 4; u += NWAVES * 64) ((LAS unsigned*)(F.lds + LDSCTL_OFF))[u] = 0u;
    __syncthreads();
    unsigned* ctl = (unsigned*)(F.ws + WS_CTL);
    XcdBarrier bar = xcd_barrier_post(ctl + CW_BAR, F.MISC + 8);
    const int lo = args.ph_lo, hi = args.ph_hi;
#define IN(k) (lo <= (k) && (k) < hi)
#define BOTH(k) (IN(k) && IN((k) + 1))
    if (IN(0)) { p0_prologue(F); if (BOTH(0)) xcd_barrier(bar); }
    if (IN(1)) { p1_norm(F); if (BOTH(1)) xcd_barrier(bar); }
    if (IN(2)) {
        pg8::Gemm g{(const bf16_t*)(F.ws + WS_H), (const bf16_t*)(F.ws + WS_WTIN), T_, NP, D_};
        pg8::StaticOrder S; S.init(T_, NP, F.G, (int)blockIdx.x);
        pg8::EpiProj E{(bf16_t*)(F.ws + WS_PROJ), NP, OQB / 256, OKB / 256, QSCALE};
        pg8::gemm_phase<pg8::EpiProj, pg8::StaticOrder, true, true>(F.lds, g, S, E);
        if (BOTH(2)) xcd_barrier(bar);
    }
#undef IN
#undef BOTH
}

template <int MODE>
__global__ void __launch_bounds__(256) k_gemm_naive(const bf16_t* __restrict__ A, const float* __restrict__ W,
                                                    bf16_t* __restrict__ Cb, float* __restrict__ Cf, int N, int ldw) {
  __shared__ float As[16][65];
  __shared__ float Bs[16][65];
  int tx = threadIdx.x & 15, ty = threadIdx.x >> 4;
  int m0 = blockIdx.y * 64, n0 = blockIdx.x * 64;
  float acc[4][4];
  for (int i = 0; i < 4; ++i) for (int j = 0; j < 4; ++j) acc[i][j] = 0.f;
  for (int k0 = 0; k0 < 1024; k0 += 16) {
    for (int e = threadIdx.x; e < 1024; e += 256) {
      int kk = e & 15, mm = e >> 4;
      As[kk][mm] = bf2f(A[(size_t)(m0 + mm) * 1024 + k0 + kk]);
      int nn = e & 63, k2 = e >> 6;
      int n = n0 + nn;
      float wv = 0.f;
      if (n < N) {
        int oc = (MODE == 0) ? orig_col(n) : n;
        wv = W[(size_t)(k0 + k2) * ldw + oc];
      }
      Bs[k2][nn] = wv;
    }
    __syncthreads();
    for (int kk = 0; kk < 16; ++kk) {
      float a[4], bb[4];
      for (int i = 0; i < 4; ++i) a[i] = As[kk][ty * 4 + i];
      for (int j = 0; j < 4; ++j) bb[j] = Bs[kk][tx * 4 + j];
      for (int i = 0; i < 4; ++i) for (int j = 0; j < 4; ++j) acc[i][j] += a[i] * bb[j];
    }
    __syncthreads();
  }
  for (int i = 0; i < 4; ++i) for (int j = 0; j < 4; ++j) {
    int m = m0 + ty * 4 + i, n = n0 + tx * 4 + j;
    if (n >= N) continue;
    if (MODE == 0) {
      if (n < NP) Cb[(size_t)m * NP + n] = f2bf(acc[i][j]);
      else Cf[(size_t)m * 8 + (n - NP)] = acc[i][j];
    } else {
      Cf[(size_t)m * 1024 + n] = acc[i][j];
    }
  }
}

__global__ void __launch_bounds__(256) k_conv(const bf16_t* __restrict__ proj, const float* __restrict__ conv_w,
                                              const float* __restrict__ conv_b, bf16_t* __restrict__ qkc) {
  int t = blockIdx.x;
  int s = t % S_;
  for (int ch = threadIdx.x; ch < 1024; ch += 256) {
    float acc = conv_b[ch];
    for (int tap = 0; tap < 4; ++tap) {
      int ss = s - 3 + tap;
      if (ss >= 0) acc += bf2f(proj[(size_t)(t - 3 + tap) * NP + ch]) * conv_w[tap * 1024 + ch];
    }
    float v = siluf(acc);
    if (ch >= 512) v *= 0.08838834764831845f;
    qkc[(size_t)t * 1024 + ch] = f2bf(v);
  }
}

__global__ void __launch_bounds__(256) k_cloc(const bf16_t* __restrict__ proj, const bf16_t* __restrict__ qkc,
                                              const float* __restrict__ gates, const float* __restrict__ b_i,
                                              const float* __restrict__ b_f, float* __restrict__ Cst,
                                              float* __restrict__ nst, float* __restrict__ amax, float* __restrict__ ftot) {
  __shared__ float logf_[64], cumf[64], a_[64], w_[64];
  __shared__ float ks[64][129];
  int bhc = blockIdx.x;
  int c = bhc & 31, h = (bhc >> 5) & 3, b = bhc >> 7;
  int t0 = b * S_ + c * 64;
  int tid = threadIdx.x;
  if (tid < 64) {
    float fp = gates[(size_t)(t0 + tid) * 8 + 4 + h] + b_f[h];
    float lf = (fp > 0.f) ? -log1pf(__expf(-fp)) : (fp - log1pf(__expf(fp)));
    logf_[tid] = lf;
  }
  for (int e = tid; e < 64 * 128; e += 256) {
    int s = e >> 7, k = e & 127;
    ks[s][k] = bf2f(qkc[(size_t)(t0 + s) * 1024 + 512 + h * 128 + k]);
  }
  __syncthreads();
  if (tid == 0) {
    float cs = 0.f;
    for (int s = 0; s < 64; ++s) { cs += logf_[s]; cumf[s] = cs; }
  }
  __syncthreads();
  if (tid < 64) {
    float ip = gates[(size_t)(t0 + tid) * 8 + h] + b_i[h];
    a_[tid] = cumf[63] - cumf[tid] + ip;
  }
  __syncthreads();
  if (tid == 0) {
    float m = a_[0];
    for (int s = 1; s < 64; ++s) m = fmaxf(m, a_[s]);
    amax[bhc] = m; ftot[bhc] = cumf[63];
    logf_[0] = m;
  }
  __syncthreads();
  if (tid < 64) w_[tid] = __expf(a_[tid] - logf_[0]);
  __syncthreads();
  int k = tid & 127;
  for (int v = (tid >> 7); v < 128; v += 2) {
    float acc = 0.f;
    for (int s = 0; s < 64; ++s) {
      float vv = bf2f(proj[(size_t)(t0 + s) * NP + OVM + h * 128 + v]);
      acc += w_[s] * vv * ks[s][k];
    }
    Cst[(size_t)bhc * 16384 + v * 128 + k] = acc;
  }
  if (tid < 128) {
    float acc = 0.f;
    for (int s = 0; s < 64; ++s) acc += w_[s] * ks[s][tid];
    nst[(size_t)bhc * 128 + tid] = acc;
  }
}

__global__ void __launch_bounds__(256) k_scan(float* __restrict__ Cst, float* __restrict__ nst,
                                              const float* __restrict__ amax, const float* __restrict__ ftot,
                                              float* __restrict__ mprev) {
  int bh = blockIdx.y;
  int e = blockIdx.x * 256 + threadIdx.x;
  if (e >= 16384 + 128) return;
  float st = 0.f, m = 0.f;
  for (int c = 0; c < 32; ++c) {
    int bhc = bh * 32 + c;
    float am = amax[bhc], ft = ftot[bhc];
    float mn = fmaxf(ft + m, am);
    float so = __expf(ft + m - mn), sn = __expf(am - mn);
    float* p = (e < 16384) ? (Cst + (size_t)bhc * 16384 + e) : (nst + (size_t)bhc * 128 + (e - 16384));
    float loc = *p;
    *p = st;
    if (e == 0) mprev[bhc] = m;
    st = so * st + sn * loc;
    m = mn;
  }
}

__global__ void __launch_bounds__(256) k_mout(const bf16_t* __restrict__ proj, const bf16_t* __restrict__ qkc,
                                              const float* __restrict__ gates, const float* __restrict__ b_i,
                                              const float* __restrict__ b_f, const float* __restrict__ Cst,
                                              const float* __restrict__ nst, const float* __restrict__ mprev,
                                              const float* __restrict__ g_head, bf16_t* __restrict__ mix) {
  __shared__ float logf_[64], cumf[64], logi[64], mt[64], isc[64], den[64], rn[64];
  __shared__ float Sm[64][65];
  __shared__ float hs[64][129];
  int bhc = blockIdx.x;
  int c = bhc & 31, h = (bhc >> 5) & 3, b = bhc >> 7;
  int t0 = b * S_ + c * 64;
  int tid = threadIdx.x;
  float mp = mprev[bhc];
  if (tid < 64) {
    float fp = gates[(size_t)(t0 + tid) * 8 + 4 + h] + b_f[h];
    float lf = (fp > 0.f) ? -log1pf(__expf(-fp)) : (fp - log1pf(__expf(fp)));
    logf_[tid] = lf;
    logi[tid] = gates[(size_t)(t0 + tid) * 8 + h] + b_i[h];
  }
  __syncthreads();
  if (tid == 0) {
    float cs = 0.f;
    for (int s = 0; s < 64; ++s) { cs += logf_[s]; cumf[s] = cs; }
  }
  __syncthreads();
  if (tid < 64) {
    int t = tid;
    float mi = cumf[t] + mp;
    float mx = -INFINITY;
    for (int s = 0; s <= t; ++s) mx = fmaxf(mx, cumf[t] - cumf[s] + logi[s]);
    float m = fmaxf(mi, mx);
    mt[t] = m;
    isc[t] = __expf(mi - m);
  }
  __syncthreads();
  const bf16_t* qb = qkc + (size_t)t0 * 1024 + h * 128;
  const bf16_t* kb = qkc + (size_t)t0 * 1024 + 512 + h * 128;
  for (int e = tid; e < 4096; e += 256) {
    int t = e >> 6, s = e & 63;
    float val = 0.f;
    if (s <= t) {
      float dot = 0.f;
      for (int k = 0; k < 128; ++k) dot += bf2f(qb[(size_t)t * 1024 + k]) * bf2f(kb[(size_t)s * 1024 + k]);
      val = dot * __expf(cumf[t] - cumf[s] + logi[s] - mt[t]);
    }
    Sm[t][s] = val;
  }
  __syncthreads();
  if (tid < 64) {
    int t = tid;
    float d = 0.f;
    for (int s = 0; s < 64; ++s) d += Sm[t][s];
    float nq = 0.f;
    for (int k = 0; k < 128; ++k) nq += nst[(size_t)bhc * 128 + k] * bf2f(qb[(size_t)t * 1024 + k]);
    d += isc[t] * nq;
    den[t] = fmaxf(fabsf(d), __expf(-mt[t]));
  }
  __syncthreads();
  for (int e = tid; e < 64 * 128; e += 256) {
    int t = e >> 7, v = e & 127;
    float acc = 0.f;
    for (int s = 0; s <= t; ++s) acc += Sm[t][s] * bf2f(proj[(size_t)(t0 + s) * NP + OVM + h * 128 + v]);
    float cq = 0.f;
    for (int k = 0; k < 128; ++k) cq += Cst[(size_t)bhc * 16384 + v * 128 + k] * bf2f(qb[(size_t)t * 1024 + k]);
    acc += isc[t] * cq;
    hs[t][v] = acc / den[t];
  }
  __syncthreads();
  if (tid < 64) {
    float ss = 0.f;
    for (int v = 0; v < 128; ++v) ss += hs[tid][v] * hs[tid][v];
    rn[tid] = rsqrtf(ss * (1.0f / 128.0f) + 1e-6f);
  }
  __syncthreads();
  for (int e = tid; e < 64 * 128; e += 256) {
    int t = e >> 7, v = e & 127;
    float hm = hs[t][v] * rn[t] * g_head[h * 128 + v];
    float om = bf2f(proj[(size_t)(t0 + t) * NP + OOM + h * 128 + v]);
    float zm = bf2f(proj[(size_t)(t0 + t) * NP + OZM + h * 128 + v]);
    mix[(size_t)(t0 + t) * 1024 + h * 128 + v] = f2bf(hm * sigmoidf_(om) * siluf(zm));
  }
}

__global__ void __launch_bounds__(64) k_kmean(const bf16_t* __restrict__ proj, float* __restrict__ kmean) {
  int bhn = blockIdx.x;
  int n = bhn & 7, h = (bhn >> 3) & 7, b = bhn >> 6;
  int d = threadIdx.x;
  float acc = 0.f;
  for (int s = 0; s < 256; ++s) acc += bf2f(proj[(size_t)(b * S_ + n * 256 + s) * NP + OKB + h * 64 + d]);
  kmean[(size_t)bhn * 64 + d] = acc * (1.0f / 256.0f);
}

__global__ void __launch_bounds__(64) k_moba(const bf16_t* __restrict__ proj, const float* __restrict__ kmean,
                                             bf16_t* __restrict__ mix) {
  int t = blockIdx.x * 64 + threadIdx.x;
  int h = blockIdx.y;
  int b = t / S_, s = t % S_;
  int j = s >> 8;
  float slope = exp2f(-(float)(h + 1));
  float q[64], o[64];
#pragma unroll
  for (int d = 0; d < 64; ++d) { q[d] = bf2f(proj[(size_t)t * NP + OQB + h * 64 + d]); o[d] = 0.f; }
  unsigned selmask = 0;
  if (j <= 3) {
    selmask = (1u << j) - 1u;
  } else {
    float gv[8];
#pragma unroll
    for (int n = 0; n < 8; ++n) {
      float acc = 0.f;
      if (n < j) {
#pragma unroll
        for (int d = 0; d < 64; ++d) acc += q[d] * kmean[(size_t)((b * 8 + h) * 8 + n) * 64 + d];
      } else acc = -INFINITY;
      gv[n] = acc;
    }
    for (int r = 0; r < 3; ++r) {
      float best = -INFINITY; int bi = -1;
#pragma unroll
      for (int n = 0; n < 8; ++n) {
        bool ok = !((selmask >> n) & 1u) && (n < j);
        if (ok && (gv[n] > best || bi < 0)) { best = gv[n]; bi = n; }
      }
      selmask |= (1u << bi);
    }
  }
  float m = -INFINITY, l = 0.f;
  for (int n = 0; n <= j; ++n) {
    bool sel = (n == j) || ((selmask >> n) & 1u);
    if (!sel) continue;
    int kend = (n == j) ? (s - j * 256 + 1) : 256;
    for (int kk = 0; kk < kend; ++kk) {
      int pk = n * 256 + kk;
      const bf16_t* kr = proj + (size_t)(b * S_ + pk) * NP + OKB + h * 64;
      float dot = 0.f;
#pragma unroll
      for (int d = 0; d < 64; ++d) dot += q[d] * bf2f(kr[d]);
      float sc = dot * 0.6931471805599453f - slope * (float)(s - pk);
      float mn = fmaxf(m, sc);
      float corr = __expf(m - mn);
      float p = __expf(sc - mn);
      l = l * corr + p;
      const bf16_t* vr = proj + (size_t)(b * S_ + pk) * NP + OVB + h * 64;
#pragma unroll
      for (int d = 0; d < 64; ++d) o[d] = o[d] * corr + p * bf2f(vr[d]);
      m = mn;
    }
  }
  float inv = 1.0f / l;
#pragma unroll
  for (int d = 0; d < 64; ++d) {
    float zb = bf2f(proj[(size_t)t * NP + OZB + h * 64 + d]);
    mix[(size_t)t * 1024 + 512 + h * 64 + d] = f2bf(o[d] * inv * siluf(zb));
  }
}

__global__ void __launch_bounds__(256) k_final(const float* __restrict__ x, const float* __restrict__ ada,
                                               const float* __restrict__ gf, float* __restrict__ out) {
  __shared__ float red[4];
  int t = blockIdx.x;
  int b = t / S_;
  float v[4];
  float ss = 0.f;
  for (int i = 0; i < 4; ++i) {
    int k = threadIdx.x + 256 * i;
    v[i] = x[(size_t)t * D_ + k] + ada[b * 3072 + 2048 + k] * out[(size_t)t * D_ + k];
    ss += v[i] * v[i];
  }
  for (int o = 32; o > 0; o >>= 1) ss += __shfl_xor(ss, o);
  if ((threadIdx.x & 63) == 0) red[threadIdx.x >> 6] = ss;
  __syncthreads();
  float tot = red[0] + red[1] + red[2] + red[3];
  float r = rsqrtf(tot * (1.0f / 1024.0f) + 1e-6f);
  for (int i = 0; i < 4; ++i) {
    int k = threadIdx.x + 256 * i;
    out[(size_t)t * D_ + k] = v[i] * r * gf[k];
  }
}


extern "C" void kernel_launch(void* const* d_in, const int* in_sizes, int n_in, void* d_out, int out_size,
                              void* d_ws, size_t ws_size, hipStream_t stream) {
  static int grid = 0;
  if (grid == 0) {
    int dev = 0, cus = 0, per_cu = 0;
    if (hipGetDevice(&dev) != hipSuccess || hipDeviceGetAttribute(&cus, hipDeviceAttributeMultiprocessorCount, dev) != hipSuccess) { grid = -1; return; }
    if (hipFuncSetAttribute((const void*)mk_fwd, hipFuncAttributeMaxDynamicSharedMemorySize, LDS_BYTES) != hipSuccess) { fprintf(stderr, "hipFuncSetAttribute failed\n"); grid = -1; return; }
    if (hipOccupancyMaxActiveBlocksPerMultiprocessor(&per_cu, (const void*)mk_fwd, NWAVES * 64, LDS_BYTES) != hipSuccess || per_cu < 1) { fprintf(stderr, "occupancy query: %d\n", per_cu); per_cu = 1; }
    (void)hipGetLastError();
    grid = cus;
    if (ws_size < WS_END) { fprintf(stderr, "workspace too small: %zu\n", ws_size); grid = -1; return; }
  }
  if (grid < 0) return;
  (void)hipMemsetAsync((char*)d_ws + WS_CTL, 0, CTL_ZERO_BYTES, stream);
  Args a{};
  for (int i = 0; i < 13; ++i) a.in[i] = (const float*)d_in[i];
  a.out = (float*)d_out; a.ws = (unsigned char*)d_ws; a.ph_lo = 0; a.ph_hi = 3;
  hipLaunchKernelGGL(mk_fwd, dim3(grid), dim3(NWAVES * 64), LDS_BYTES, stream, a);

  const float* x = (const float*)d_in[0];
  const float* conv_w = (const float*)d_in[6];
  const float* conv_b = (const float*)d_in[7];
  const float* b_ig = (const float*)d_in[8];
  const float* b_fg = (const float*)d_in[9];
  const float* g_head = (const float*)d_in[10];
  const float* w_out = (const float*)d_in[11];
  const float* g_final = (const float*)d_in[12];
  float* out = (float*)d_out;
  char* ws = (char*)d_ws;
  bf16_t* proj = (bf16_t*)(ws + WS_PROJ);
  bf16_t* mix = (bf16_t*)(ws + WS_H);
  bf16_t* qkc = (bf16_t*)(ws + WS_QKC);
  float* gates = (float*)(ws + WS_GATES);
  float* ada = (float*)(ws + WS_ADA);
  float* kmean = (float*)(ws + WS_KMEAN);
  float* nst = (float*)(ws + WS_SMALL);
  float* amax = nst + 1024 * 128;
  float* ftot = amax + 1024;
  float* mprev = ftot + 1024;
  float* Cst = (float*)d_out;
  k_conv<<<T_, 256, 0, stream>>>(proj, conv_w, conv_b, qkc);
  k_cloc<<<1024, 256, 0, stream>>>(proj, qkc, gates, b_ig, b_fg, Cst, nst, amax, ftot);
  k_scan<<<dim3((16384 + 128 + 255) / 256, 32), 256, 0, stream>>>(Cst, nst, amax, ftot, mprev);
  k_mout<<<1024, 256, 0, stream>>>(proj, qkc, gates, b_ig, b_fg, Cst, nst, mprev, g_head, mix);
  k_kmean<<<512, 64, 0, stream>>>(proj, kmean);
  k_moba<<<dim3(T_ / 64, 8), 64, 0, stream>>>(proj, kmean, mix);
  k_gemm_naive<1><<<dim3(1024 / 64, T_ / 64), 256, 0, stream>>>(mix, w_out, nullptr, out, 1024, 1024);
  k_final<<<T_, 256, 0, stream>>>(x, ada, g_final, out);
}
```

```cpp
#include <hip/hip_runtime.h>
#include <cstdio>
#include <cstdint>

#define B_ 8
#define S_ 2048
#define D_ 1024
#define T_ (B_ * S_)
#define NP 4608
#define NPROJ 4616
#define OQM 0
#define OKM 512
#define OVM 1024
#define OOM 1536
#define OZM 2048
#define OQB 2560
#define OKB 3072
#define OVB 3584
#define OZB 4096
#define NKS 16

typedef unsigned short bf16_t;
namespace pg8 {
#define PG8_LAS __attribute__((address_space(3)))
typedef unsigned short bf16_t;
typedef short bf16x8 __attribute__((ext_vector_type(8)));
typedef float f32x4 __attribute__((ext_vector_type(4)));
typedef unsigned u32x4 __attribute__((ext_vector_type(4)));
constexpr int BM = 256, BK = 64, HALF = 128, HTB = HALF * BK * 2  , STAGE_BYTES = 8 * HTB, NXCD = 8, WGM = 8;

__host__ __device__ __forceinline__ int lds_byte(int r, int c) { const int st = (r >> 4) * 2 + (c >> 5), rr = r & 15, cc = c & 31, ob = rr * 64 + cc * 2; return st * 1024 + (ob ^ (((ob >> 9) & 1) << 5)); }
__host__ __device__ __forceinline__ void stage_rc(int b, int& R, int& C) { const int st = b / 1024, sb = b % 1024, swz = sb ^ (((sb >> 9) & 1) << 5); R = (st >> 1) * 16 + swz / 64; C = (st & 1) * 32 + (swz % 64) / 2; }
__host__ __device__ __forceinline__ int perm32(int rho) { const int n = rho >> 4, i = rho & 15; return 8 * (i >> 2) + 4 * n + (i & 3); }

struct Unit { int pm, pn; };
struct Gemm { const bf16_t* A; const bf16_t* Bt; int M, N, K; };

struct StaticOrder {
    int nM, nN, nwg, G, c;
    __host__ __device__ void init(int M, int N, int G_, int c_) { nM = M / BM; nN = N / BM; nwg = nM * nN; G = G_; c = c_; }
    __host__ __device__ bool next(int i, Unit& u) const {
        const long L = (long)i * G + c; if (L >= nwg) return false;
        int wgid = (int)L; { const int q = nwg / NXCD, r = nwg % NXCD, xcd = wgid % NXCD, off = wgid / NXCD; wgid = (xcd < r ? xcd * (q + 1) : r * (q + 1) + (xcd - r) * q) + off; }
        const int nig = WGM * nN, gid = wgid / nig, fm = gid * WGM, gsz = (nM - fm) < WGM ? (nM - fm) : WGM;
        u.pm = fm + ((wgid % nig) % gsz); u.pn = (wgid % nig) / gsz; return true;
    }
    __device__ __forceinline__ void a_ready(const Unit&) const {}
    __device__ __forceinline__ void done(const Unit&) const {}
};

__device__ __forceinline__ unsigned cvt_pk_bf16(float lo, float hi) { unsigned r; asm volatile("v_cvt_pk_bf16_f32 %0, %1, %2" : "=v"(r) : "v"(lo), "v"(hi)); return r; }

struct EpiProj {
    static constexpr bool PERM = true, AFTER_DRAIN = false;
    bf16_t* O; int ldc; int qt_lo, qt_hi; float qscale;
    __device__ __forceinline__ void operator()(const f32x4 (&acc)[2][2][4][2], const Unit& u, int wr, int wc, int fr, int fq) const {
        const int row0 = u.pm * BM + wr * 64 + fr; const int col0 = u.pn * BM + wc * 32 + 8 * fq;
        const float sc = (u.pn >= qt_lo && u.pn < qt_hi) ? qscale : 1.f;
#pragma unroll
        for (int ai = 0; ai < 2; ++ai)
#pragma unroll
            for (int m = 0; m < 4; ++m) { bf16_t* rowp = O + (size_t)(row0 + ai * HALF + m * 16) * ldc + col0;
#pragma unroll
                for (int bj = 0; bj < 2; ++bj) { f32x4 v0 = acc[ai][bj][m][0] * sc, v1 = acc[ai][bj][m][1] * sc;
                    u32x4 w; w.x = cvt_pk_bf16(v0[0], v0[1]); w.y = cvt_pk_bf16(v0[2], v0[3]); w.z = cvt_pk_bf16(v1[0], v1[1]); w.w = cvt_pk_bf16(v1[2], v1[3]);
                    *(u32x4*)(rowp + bj * HALF) = w; } }
    }
};
struct EpiOut {
    static constexpr bool PERM = false, AFTER_DRAIN = false;
    const float* X; const float* gate; float* XN; float* rowss;
    __device__ __forceinline__ void operator()(const f32x4 (&acc)[2][2][4][2], const Unit& u, int wr, int wc, int fr, int fq) const {
        const int row0 = u.pm * BM + wr * 64 + fr, col0 = u.pn * BM + wc * 32 + 4 * fq;
        const float* gb = gate + (size_t)((u.pm * BM) / 2048) * 3072 + 2048;
        f32x4 gv[2][2];
#pragma unroll
        for (int bj = 0; bj < 2; ++bj)
#pragma unroll
            for (int n = 0; n < 2; ++n) gv[bj][n] = *(const f32x4*)(gb + col0 + bj * HALF + n * 16);
#pragma unroll
        for (int ai = 0; ai < 2; ++ai)
#pragma unroll
            for (int m = 0; m < 4; ++m) { const size_t ro = (size_t)(row0 + ai * HALF + m * 16) * 1024 + col0; float ss = 0.f;
#pragma unroll
                for (int bj = 0; bj < 2; ++bj)
#pragma unroll
                    for (int n = 0; n < 2; ++n) { const f32x4 xv = *(const f32x4*)(X + ro + bj * HALF + n * 16); const f32x4 r = xv + gv[bj][n] * acc[ai][bj][m][n];
                        ss += r[0] * r[0] + r[1] * r[1] + r[2] * r[2] + r[3] * r[3]; *(f32x4*)(XN + ro + bj * HALF + n * 16) = r; }
                ss += __shfl_xor(ss, 16); ss += __shfl_xor(ss, 32);
                if (fq == 0) rowss[((size_t)(row0 + ai * HALF + m * 16) * 4 + u.pn) * 4 + wc] = ss; }
    }
};
template <class Epi, class Sched, bool ALIGN_EPI = false, bool SP2 = false>
__device__ __forceinline__ void gemm_phase(PG8_LAS unsigned char* lds, const Gemm g, const Sched& S, const Epi& E) {
    const int tid = threadIdx.x, wid = __builtin_amdgcn_readfirstlane(tid >> 6), lane = tid & 63, wr = wid >> 2, wc = wid & 3, fr = lane & 15, fq = lane >> 4;
    const int K = g.K, nt = K / BK;
    unsigned voffA[2], voffB[2];
#pragma unroll
    for (int i = 0; i < 2; ++i) { int R, C; stage_rc(tid * 16 + i * 8192, R, C); const int Rb = Epi::PERM ? ((R & ~31) + perm32(R & 31)) : R;
        voffA[i] = (unsigned)(R * K + C) * 2u; voffB[i] = (unsigned)(Rb * K + C) * 2u; }
    const size_t kstep = (size_t)(BK * 2);
    const size_t hstep = (size_t)HALF * K * 2;
    const size_t tstep = 2 * hstep;
    const unsigned ldsw = (unsigned)wid * 1024u;
    const int aoff = lds_byte(wr * 64 + fr, fq * 8), boff = lds_byte(wc * 32 + fr, fq * 8);
#define PG8_SA(b, h) (((b) * 2 + (h)) * HTB)
#define PG8_SB(b, h) ((4 + (b) * 2 + (h)) * HTB)
#define PG8_STAGE(bufoff, gbase, voff) do { _Pragma("unroll") for (int _i = 0; _i < 2; ++_i) \
        __builtin_amdgcn_global_load_lds((const unsigned*)((const char*)(gbase) + (voff)[_i]), (PG8_LAS unsigned*)(lds + (bufoff) + ldsw + _i * 8192), 16, 0, 0); } while (0)
#define PG8_LDA(dst, b, h) do { _Pragma("unroll") for (int m = 0; m < 4; ++m) _Pragma("unroll") for (int k = 0; k < 2; ++k) dst[m][k] = *(const PG8_LAS bf16x8*)(lds + PG8_SA(b, h) + aoff + m * 2048 + k * 1024); } while (0)
#define PG8_LDB(dst, b, h) do { _Pragma("unroll") for (int n = 0; n < 2; ++n) _Pragma("unroll") for (int k = 0; k < 2; ++k) dst[n][k] = *(const PG8_LAS bf16x8*)(lds + PG8_SB(b, h) + boff + n * 2048 + k * 1024); } while (0)
#define PG8_MMA(ai, bj, At, Bt) do { __builtin_amdgcn_s_setprio(1); _Pragma("unroll") for (int m = 0; m < 4; ++m) _Pragma("unroll") for (int n = 0; n < 2; ++n) _Pragma("unroll") for (int k = 0; k < 2; ++k) \
        acc[ai][bj][m][n] = __builtin_amdgcn_mfma_f32_16x16x32_bf16(Bt[n][k], At[m][k], acc[ai][bj][m][n], 0, 0, 0); __builtin_amdgcn_s_setprio(0); } while (0)
#define PG8_WAIT_V(n) asm volatile("s_waitcnt vmcnt(" #n ")" ::: "memory")
#define PG8_WAIT_L(n) asm volatile("s_waitcnt lgkmcnt(" #n ")" ::: "memory")
#define PG8_BAR __builtin_amdgcn_s_barrier()
#define PG8_SCHED __builtin_amdgcn_sched_barrier(0)
    Unit cur, nxt; int ui = 0;
    if (!S.next(0, cur)) return;
    f32x4 acc[2][2][4][2];
#pragma unroll
    for (int a = 0; a < 2; ++a)
#pragma unroll
        for (int b = 0; b < 2; ++b)
#pragma unroll
            for (int m = 0; m < 4; ++m)
#pragma unroll
                for (int n = 0; n < 2; ++n) acc[a][b][m][n] = (f32x4){0.f, 0.f, 0.f, 0.f};
    bf16x8 At[4][2], B0[2][2], B1[2][2];
    const char* cA = (const char*)g.A + (size_t)cur.pm * tstep; const char* cB = (const char*)g.Bt + (size_t)cur.pn * tstep;
    S.a_ready(cur);
    if constexpr (SP2) {
        PG8_STAGE(PG8_SB(0, 0), cB, voffB); PG8_STAGE(PG8_SB(0, 1), cB + hstep, voffB); PG8_STAGE(PG8_SA(0, 0), cA, voffA); PG8_STAGE(PG8_SA(0, 1), cA + hstep, voffA);
        if (wr == 1) PG8_BAR;
        PG8_WAIT_V(2); PG8_BAR;
        PG8_STAGE(PG8_SB(1, 0), cB + kstep, voffB); PG8_STAGE(PG8_SA(1, 0), cA + kstep, voffA); PG8_STAGE(PG8_SB(1, 1), cB + hstep + kstep, voffB);
        PG8_WAIT_V(6); PG8_BAR;
    } else {
        PG8_STAGE(PG8_SB(0, 0), cB, voffB); PG8_STAGE(PG8_SA(0, 0), cA, voffA); PG8_STAGE(PG8_SB(0, 1), cB + hstep, voffB); PG8_STAGE(PG8_SA(0, 1), cA + hstep, voffA);
        if (wr == 1) PG8_BAR;
        PG8_WAIT_V(4); PG8_BAR;
        PG8_STAGE(PG8_SB(1, 0), cB + kstep, voffB); PG8_STAGE(PG8_SA(1, 0), cA + kstep, voffA); PG8_STAGE(PG8_SB(1, 1), cB + hstep + kstep, voffB);
        PG8_WAIT_V(6); PG8_BAR;
    }
    for (;;) {
        const bool has_next = S.next(ui + 1, nxt);
        const char* nA = has_next ? (const char*)g.A + (size_t)nxt.pm * tstep : cA; const char* nB = has_next ? (const char*)g.Bt + (size_t)nxt.pn * tstep : cB;
        for (int t = 0; t < nt; t += 2) {
            const bool last = (t == nt - 2);
            const char* a1 = cA + (size_t)(t + 1) * kstep;
            const char* a2 = last ? nA : cA + (size_t)(t + 2) * kstep; const char* b2 = last ? nB : cB + (size_t)(t + 2) * kstep;
            const char* a3 = a2 + kstep; const char* b3 = b2 + kstep;
            if (last && has_next) S.a_ready(nxt);
            if constexpr (SP2) {
            PG8_LDB(B0, 0, 0); PG8_LDB(B1, 0, 1); PG8_SCHED; PG8_LDA(At, 0, 0); PG8_STAGE(PG8_SA(1, 1), a1 + hstep, voffA);
            PG8_WAIT_V(8); PG8_WAIT_L(0); PG8_BAR; PG8_MMA(0, 0, At, B0); PG8_MMA(0, 1, At, B1); PG8_BAR; PG8_SCHED;
            PG8_LDA(At, 0, 1); PG8_STAGE(PG8_SB(0, 0), b2, voffB); PG8_STAGE(PG8_SB(0, 1), b2 + hstep, voffB); PG8_STAGE(PG8_SA(0, 0), a2, voffA);
            PG8_WAIT_V(8); PG8_WAIT_L(0); PG8_BAR; PG8_MMA(1, 0, At, B0); PG8_MMA(1, 1, At, B1); PG8_BAR; PG8_SCHED;
            PG8_LDB(B0, 1, 0); PG8_LDB(B1, 1, 1); PG8_SCHED; PG8_LDA(At, 1, 0); PG8_STAGE(PG8_SA(0, 1), a2 + hstep, voffA);
            PG8_WAIT_V(8); PG8_WAIT_L(0); PG8_BAR; PG8_MMA(0, 0, At, B0); PG8_MMA(0, 1, At, B1); PG8_BAR; PG8_SCHED;
            PG8_LDA(At, 1, 1); PG8_STAGE(PG8_SB(1, 0), b3, voffB); PG8_STAGE(PG8_SB(1, 1), b3 + hstep, voffB); PG8_STAGE(PG8_SA(1, 0), a3, voffA);
            PG8_WAIT_V(8); PG8_WAIT_L(0); PG8_BAR; PG8_MMA(1, 0, At, B0); PG8_MMA(1, 1, At, B1); PG8_BAR; PG8_SCHED;
            } else {
            PG8_LDB(B0, 0, 0); PG8_SCHED; PG8_LDA(At, 0, 0); PG8_STAGE(PG8_SA(1, 1), a1 + hstep, voffA);
            PG8_WAIT_L(8); PG8_BAR; PG8_WAIT_L(0); PG8_MMA(0, 0, At, B0); PG8_BAR; PG8_SCHED;
            PG8_LDB(B1, 0, 1); PG8_STAGE(PG8_SB(0, 0), b2, voffB);
            PG8_BAR; PG8_WAIT_L(0); PG8_MMA(0, 1, At, B1); PG8_BAR;
            PG8_LDA(At, 0, 1); PG8_STAGE(PG8_SA(0, 0), a2, voffA);
            PG8_BAR; PG8_WAIT_L(0); PG8_MMA(1, 0, At, B0); PG8_BAR; PG8_SCHED;
            PG8_STAGE(PG8_SB(0, 1), b2 + hstep, voffB);
            PG8_WAIT_V(6); PG8_BAR; PG8_MMA(1, 1, At, B1); PG8_BAR;
            PG8_LDB(B0, 1, 0); PG8_SCHED; PG8_LDA(At, 1, 0); PG8_STAGE(PG8_SA(0, 1), a2 + hstep, voffA);
            PG8_WAIT_L(8); PG8_BAR; PG8_WAIT_L(0); PG8_MMA(0, 0, At, B0); PG8_BAR; PG8_SCHED;
            PG8_LDB(B1, 1, 1); PG8_STAGE(PG8_SB(1, 0), b3, voffB);
            PG8_BAR; PG8_WAIT_L(0); PG8_MMA(0, 1, At, B1); PG8_BAR;
            PG8_LDA(At, 1, 1); PG8_STAGE(PG8_SA(1, 0), a3, voffA);
            PG8_BAR; PG8_WAIT_L(0); PG8_MMA(1, 0, At, B0); PG8_BAR; PG8_SCHED;
            PG8_STAGE(PG8_SB(1, 1), b3 + hstep, voffB);
            PG8_WAIT_V(6); PG8_BAR; PG8_MMA(1, 1, At, B1); PG8_BAR;
            }
        }
        if constexpr (ALIGN_EPI) { if (wr == 0) PG8_BAR; }
        if constexpr (!Epi::AFTER_DRAIN) { E(acc, cur, wr, wc, fr, fq); S.done(cur); }
        if (!has_next) break;
#pragma unroll
        for (int a = 0; a < 2; ++a)
#pragma unroll
            for (int b = 0; b < 2; ++b)
#pragma unroll
                for (int m = 0; m < 4; ++m)
#pragma unroll
                    for (int n = 0; n < 2; ++n) acc[a][b][m][n] = (f32x4){0.f, 0.f, 0.f, 0.f};
        cur = nxt; cA = nA; cB = nB; ++ui;
        if constexpr (ALIGN_EPI) { if (wr == 1) PG8_BAR; }
    }
    PG8_WAIT_V(0);
    if constexpr (!ALIGN_EPI) { if (wr == 0) PG8_BAR; }
    PG8_BAR;
    if constexpr (Epi::AFTER_DRAIN) { E.fused(acc, cur, wr, wc, fr, fq, lds, wid, lane); S.done(cur); }
#undef PG8_SA
#undef PG8_SB
#undef PG8_STAGE
#undef PG8_LDA
#undef PG8_LDB
#undef PG8_MMA
#undef PG8_WAIT_V
#undef PG8_WAIT_L
#undef PG8_BAR
#undef PG8_SCHED
}
}

constexpr int NWAVES = 8;
constexpr size_t MiB = 1u << 20;
constexpr size_t WS_CTL = 0, CTL_ZERO_BYTES = 1 * MiB;
constexpr size_t WS_WTIN = 1 * MiB;
constexpr size_t WS_WTOUT = 10 * MiB;
constexpr size_t WS_ADAP = 12 * MiB;
constexpr size_t WS_ADA = 14 * MiB;
constexpr size_t WS_KMEAN = 14 * MiB + 128 * 1024;
constexpr size_t WS_GATES = 14 * MiB + 512 * 1024;
constexpr size_t WS_ROWSS = 15 * MiB;
constexpr size_t WS_MST = 16 * MiB;
constexpr size_t WS_H = 32 * MiB;
constexpr size_t WS_PROJ = 64 * MiB;
constexpr size_t WS_QKC = 208 * MiB;
constexpr size_t WS_SMALL = 240 * MiB;
constexpr size_t WS_END = 256 * MiB;
constexpr int CW_BAR = 4096;

constexpr int RING_BYTES = 131072;
constexpr int LDSCTL_OFF = RING_BYTES, MISC_OFF = LDSCTL_OFF + 320;
constexpr int LDS_BYTES = 147456;

#define GAS __attribute__((address_space(1)))
#define LAS __attribute__((address_space(3)))
typedef unsigned v4u __attribute__((ext_vector_type(4)));
typedef float f32x4 __attribute__((ext_vector_type(4)));
typedef short bf16x8 __attribute__((ext_vector_type(8)));
#define LDS_WAIT() asm volatile("s_waitcnt lgkmcnt(0)" ::: "memory")
#define VM_WAIT() asm volatile("s_waitcnt vmcnt(0)" ::: "memory")
__device__ __forceinline__ unsigned f2bf(float f) { unsigned u = __builtin_bit_cast(unsigned, f); return (u + 0x7fffu + ((u >> 16) & 1u)) >> 16; }
__device__ __forceinline__ unsigned pk2(float lo, float hi) { return f2bf(lo) | (f2bf(hi) << 16); }
__device__ __forceinline__ float bf2f(bf16_t h) { return __uint_as_float(((unsigned)h) << 16); }
__device__ __forceinline__ float siluf(float v) { return v / (1.0f + __expf(-v)); }
__device__ __forceinline__ float sigmoidf_(float v) { return 1.0f / (1.0f + __expf(-v)); }
__device__ __forceinline__ int orig_col(int np) { return np < 2048 ? np : np + 8; }

#define XB_TMO      128
#define XB_XCNT(j)  (256  + 64 * (j))
#define XB_XSUB(j)  (1280 + 64 * (j))
#define XB_XGEN(j)  (2304 + 64 * (j))
#define XB_TOP      3328
#define XB_TOPGEN   3392
#define XCD_BAR_WORDS 3456
#define XB_SPIN_CAP (1u << 18)
__device__ __forceinline__ unsigned xb_ld(unsigned* p)              { return __hip_atomic_load(p, __ATOMIC_RELAXED, __HIP_MEMORY_SCOPE_AGENT); }
__device__ __forceinline__ unsigned xb_add(unsigned* p, unsigned v) { return __hip_atomic_fetch_add(p, v, __ATOMIC_RELAXED, __HIP_MEMORY_SCOPE_AGENT); }
__device__ __forceinline__ unsigned xb_xcc_id() { return (unsigned)__builtin_amdgcn_s_getreg((3 << 11) | 20) & 0xFu; }
#define XB_SPIN(cond, bar) do { unsigned _sp = 0; while (cond) { __builtin_amdgcn_s_sleep(1); \
    if ((++_sp & 255u) == 0u) { if (xb_ld(&(bar)[XB_TMO])) break; if (_sp > XB_SPIN_CAP) { atomicAdd(&(bar)[XB_TMO], 1u); break; } } } } while (0)
struct XcdBarrier { unsigned* bar; unsigned x; volatile LAS unsigned* st; };
__device__ __forceinline__ XcdBarrier xcd_barrier_post(unsigned* bar, volatile LAS unsigned* st) {
    XcdBarrier b; b.bar = bar; b.x = xb_xcc_id(); b.st = st;
    if (threadIdx.x == 0) (void)xb_add(&bar[XB_XCNT(b.x)], 1u);
    return b;
}
__device__ __forceinline__ void xcd_barrier_complete(unsigned* bar, unsigned x, unsigned& nloc, unsigned& nx) {
    const unsigned G = gridDim.x * gridDim.y * gridDim.z;
    unsigned sum, cnt, mine, sp = 0u;
    for (;;) {
        sum = 0u; cnt = 0u; mine = 0u;
#pragma unroll
        for (unsigned j = 0; j < 16; ++j) { const unsigned c = xb_ld(&bar[XB_XCNT(j)]); sum += c; cnt += (c > 0u) ? 1u : 0u; mine = (j == x) ? c : mine; }
        if (sum == G) break;
        __builtin_amdgcn_s_sleep(1);
        if ((++sp & 255u) == 0u) { if (xb_ld(&bar[XB_TMO])) break; if (sp > XB_SPIN_CAP) { atomicAdd(&bar[XB_TMO], 1u); break; } }
    }
    nloc = mine > 0u ? mine : 1u; nx = cnt > 0u ? cnt : 1u;
}
__device__ __forceinline__ void xcd_barrier(const XcdBarrier& b) {
    asm volatile("s_waitcnt vmcnt(0)" ::: "memory");
    __syncthreads();
    if (threadIdx.x == 0) {
        unsigned* bar = b.bar;
        __builtin_amdgcn_s_waitcnt(0);
        unsigned nloc = b.st[0], nx = b.st[1];
        if (nloc == 0u) { xcd_barrier_complete(bar, b.x, nloc, nx); b.st[0] = nloc; b.st[1] = nx; }
        const unsigned old = xb_add(&bar[XB_XSUB(b.x)], 1u);
        const unsigned gen = old / nloc;
        if (old + 1u == (gen + 1u) * nloc) {
            __builtin_amdgcn_fence(__ATOMIC_RELEASE, "agent");
            asm volatile("s_waitcnt vmcnt(0)" ::: "memory");
            const unsigned og = xb_add(&bar[XB_TOP], 1u);
            const unsigned tg = og / nx;
            if (og + 1u == (tg + 1u) * nx) xb_add(&bar[XB_TOPGEN], 1u);
            else XB_SPIN(xb_ld(&bar[XB_TOPGEN]) == tg, bar);
            __builtin_amdgcn_fence(__ATOMIC_ACQUIRE, "agent");
            xb_add(&bar[XB_XGEN(b.x)], 1u);
            asm volatile("s_waitcnt vmcnt(0)" ::: "memory");
        } else {
            XB_SPIN(xb_ld(&bar[XB_XGEN(b.x)]) == gen, bar);
            __builtin_amdgcn_fence(__ATOMIC_ACQUIRE, "agent");
            asm volatile("s_waitcnt vmcnt(0)" ::: "memory");
        }
    }
    __syncthreads();
}

struct Frame {
    LAS unsigned char* lds;
    volatile LAS unsigned* MISC;
    int tid, lane, wave, vcu, G;
    const float *x, *c, *w_ada, *b_ada, *g_norm, *w_in, *conv_w, *conv_b, *b_ig, *b_fg, *g_head, *w_out, *g_final;
    float* out;
    unsigned char* ws;
};
__device__ __forceinline__ float wave_sum(float v) {
#pragma unroll
    for (int o = 1; o < 64; o <<= 1) v += __shfl_xor(v, o);
    return v;
}

__device__ __forceinline__ void p0_transpose_item(const float* W, int ldw, bool remap, bf16_t* WT, LAS float* scr, int kb, int nb, int lane) {
    const int k0 = 64 * kb, n0 = 32 * nb; const int c0 = remap ? orig_col(n0) : n0;
#pragma unroll 8
    for (int i = 0; i < 32; ++i) { const int kk = 2 * i + (lane >> 5); scr[kk * 33 + (lane & 31)] = W[(size_t)(k0 + kk) * ldw + c0 + (lane & 31)]; }
    LDS_WAIT(); asm volatile("" ::: "memory");
    const int c = lane & 7;
#pragma unroll
    for (int j = 0; j < 4; ++j) { const int n = (lane >> 3) + 8 * j; const LAS float* s = scr + (8 * c) * 33 + n;
        v4u o; o.x = pk2(s[0 * 33], s[1 * 33]); o.y = pk2(s[2 * 33], s[3 * 33]); o.z = pk2(s[4 * 33], s[5 * 33]); o.w = pk2(s[6 * 33], s[7 * 33]);
        *(GAS v4u*)(WT + (size_t)(n0 + n) * 1024 + k0 + 8 * c) = o; }
    LDS_WAIT(); asm volatile("" ::: "memory");
}
__device__ __forceinline__ void p0_prologue(Frame& F) {
    LAS float* scr = (LAS float*)(F.lds + F.wave * 8448);
    LAS float* sc = (LAS float*)(F.lds + 69632);
    for (int e = F.tid; e < 8192; e += NWAVES * 64) { const int b = e >> 10, k = e & 1023; sc[k * 8 + b] = siluf(F.c[e]); }
    __syncthreads();
    const int gw = F.vcu * NWAVES + F.wave, NGW = F.G * NWAVES;
    constexpr int I_ADA = 48 * NKS, I_IN = 16 * (NP / 32), I_OUT = 16 * 32;
    float* adaP = (float*)(F.ws + WS_ADAP);
    bf16_t* WtIn = (bf16_t*)(F.ws + WS_WTIN); bf16_t* WtOut = (bf16_t*)(F.ws + WS_WTOUT);
    for (int it = gw; it < I_ADA + I_IN + I_OUT; it += NGW) {
        int r = it;
        if (r < I_ADA) {
            const int cg = r % 48, ks = r / 48, j = cg * 64 + F.lane;
            float acc[8];
#pragma unroll
            for (int b = 0; b < 8; ++b) acc[b] = 0.f;
            const float* wp = F.w_ada + (size_t)(ks * 64) * 3072 + j;
#pragma unroll 4
            for (int k = 0; k < 64; ++k) { const float w = wp[(size_t)k * 3072];
                const f32x4 s0 = *(const LAS f32x4*)(sc + (ks * 64 + k) * 8), s1 = *(const LAS f32x4*)(sc + (ks * 64 + k) * 8 + 4);
                acc[0] += s0[0] * w; acc[1] += s0[1] * w; acc[2] += s0[2] * w; acc[3] += s0[3] * w;
                acc[4] += s1[0] * w; acc[5] += s1[1] * w; acc[6] += s1[2] * w; acc[7] += s1[3] * w; }
#pragma unroll
            for (int b = 0; b < 8; ++b) adaP[((size_t)ks * 8 + b) * 3072 + j] = acc[b];
            continue;
        }
        r -= I_ADA;
        if (r < I_IN) { p0_transpose_item(F.w_in, NPROJ, true, WtIn, scr, r / (NP / 32), r % (NP / 32), F.lane); continue; }
        r -= I_IN;
        p0_transpose_item(F.w_out, 1024, false, WtOut, scr, r / 32, r % 32, F.lane);
    }
}

__device__ __forceinline__ void p1_norm(Frame& F) {
    LAS float* gs = (LAS float*)(F.lds); LAS float* sh = gs + 1024;
    const float* adaP = (const float*)(F.ws + WS_ADAP);
    float* ada = (float*)(F.ws + WS_ADA);
    if (true) { for (int e = blockIdx.x * (NWAVES * 64) + F.tid; e < 8 * 3072; e += F.G * NWAVES * 64) { float v = F.b_ada[e % 3072];
#pragma unroll
        for (int s = 0; s < NKS; ++s) v += adaP[(size_t)s * 8 * 3072 + e];
        ada[e] = v; } }
    bf16_t* H = (bf16_t*)(F.ws + WS_H); float* gates = (float*)(F.ws + WS_GATES);
    f32x4 wg[4][4][2];
#pragma unroll
    for (int j = 0; j < 4; ++j)
#pragma unroll
        for (int i = 0; i < 4; ++i) { const float* wp = F.w_in + (size_t)(4 * F.lane + 256 * j + i) * NPROJ + 2048; wg[j][i][0] = *(const f32x4*)wp; wg[j][i][1] = *(const f32x4*)(wp + 4); }
    for (int rb = F.vcu; rb < T_ / 64; rb += F.G) {
        const int r0 = 64 * rb, b = r0 / S_;
        for (int k = F.tid; k < 1024; k += NWAVES * 64) {
            float scl = F.b_ada[1024 + k], sft = F.b_ada[k];
#pragma unroll
            for (int s = 0; s < NKS; ++s) { scl += adaP[((size_t)s * 8 + b) * 3072 + 1024 + k]; sft += adaP[((size_t)s * 8 + b) * 3072 + k]; }
            gs[k] = F.g_norm[k] * (1.0f + scl); sh[k] = sft;
        }
        __syncthreads();
        f32x4 gsv[4], shv[4];
#pragma unroll
        for (int j = 0; j < 4; ++j) { gsv[j] = *(const LAS f32x4*)(gs + 4 * F.lane + 256 * j); shv[j] = *(const LAS f32x4*)(sh + 4 * F.lane + 256 * j); }
        for (int rr = 0; rr < 8; ++rr) {
            const int m = r0 + F.wave * 8 + rr;
            const GAS f32x4* xr = (const GAS f32x4*)(F.x + (size_t)m * D_) + F.lane;
            f32x4 v[4]; float s = 0.f;
#pragma unroll
            for (int j = 0; j < 4; ++j) { v[j] = xr[64 * j]; s += (v[j].x * v[j].x + v[j].y * v[j].y) + (v[j].z * v[j].z + v[j].w * v[j].w); }
            const float rstd = rsqrtf(wave_sum(s) * (1.f / D_) + 1e-6f);
            float ga[8];
#pragma unroll
            for (int c = 0; c < 8; ++c) ga[c] = 0.f;
            GAS unsigned long long* o8 = (GAS unsigned long long*)(H + (size_t)m * D_) + F.lane;
#pragma unroll
            for (int j = 0; j < 4; ++j) {
                f32x4 hv = v[j] * rstd * gsv[j] + shv[j];
                o8[64 * j] = (unsigned long long)pk2(hv.x, hv.y) | ((unsigned long long)pk2(hv.z, hv.w) << 32);
#pragma unroll
                for (int i = 0; i < 4; ++i)
#pragma unroll
                    for (int c = 0; c < 8; ++c) ga[c] += hv[i] * wg[j][i][c >> 2][c & 3];
            }
#pragma unroll
            for (int c = 0; c < 8; ++c) ga[c] = wave_sum(ga[c]);
            if (F.lane == 0) { *(f32x4*)(gates + (size_t)m * 8) = (f32x4){ga[0], ga[1], ga[2], ga[3]}; *(f32x4*)(gates + (size_t)m * 8 + 4) = (f32x4){ga[4], ga[5], ga[6], ga[7]}; }
        }
        __syncthreads();
    }
}

constexpr float QSCALE = 0.125f * 1.4426950408889634f;

__device__ __forceinline__ void p6_final(Frame& F) {
    const int gw = F.vcu * NWAVES + F.wave, NGW = F.G * NWAVES;
    const float* rowss = (const float*)(F.ws + WS_ROWSS);
    f32x4 gf[4];
#pragma unroll
    for (int j = 0; j < 4; ++j) gf[j] = *(const f32x4*)(F.g_final + 4 * F.lane + 256 * j);
    for (int m = gw; m < T_; m += NGW) {
        const f32x4* pr = (const f32x4*)(rowss + (size_t)m * 16);
        const f32x4 p0 = pr[0], p1 = pr[1], p2 = pr[2], p3 = pr[3];
        const float ss = ((p0[0] + p0[1]) + (p0[2] + p0[3])) + ((p1[0] + p1[1]) + (p1[2] + p1[3])) + ((p2[0] + p2[1]) + (p2[2] + p2[3])) + ((p3[0] + p3[1]) + (p3[2] + p3[3]));
        const float rstd = rsqrtf(ss * (1.f / D_) + 1e-6f);
        GAS f32x4* xr = (GAS f32x4*)(F.out + (size_t)m * D_) + F.lane;
#pragma unroll
        for (int j = 0; j < 4; ++j) { f32x4 v = xr[64 * j]; xr[64 * j] = v * rstd * gf[j]; }
    }
}

struct Args { const float* in[13]; float* out; unsigned char* ws; int ph_lo, ph_hi, li, pad; };
__global__ void __launch_bounds__(NWAVES * 64, 2) mk_fwd(Args args) {
    extern __shared__ __attribute__((aligned(16))) unsigned char lds[];
    Frame F;
    F.lds = (LAS unsigned char*)lds;
    F.MISC = (volatile LAS unsigned*)(F.lds + MISC_OFF);
    F.tid = threadIdx.x; F.lane = F.tid & 63; F.wave = __builtin_amdgcn_readfirstlane(F.tid >> 6);
    F.G = gridDim.x; { const int bx = blockIdx.x; F.vcu = (F.G % 8 == 0) ? (bx % 8) * (F.G / 8) + bx / 8 : bx; }
    F.x = args.in[0]; F.c = args.in[1]; F.w_ada = args.in[2]; F.b_ada = args.in[3]; F.g_norm = args.in[4]; F.w_in = args.in[5];
    F.conv_w = args.in[6]; F.conv_b = args.in[7]; F.b_ig = args.in[8]; F.b_fg = args.in[9]; F.g_head = args.in[10]; F.w_out = args.in[11]; F.g_final = args.in[12];
    F.out = args.out; F.ws = args.ws;
    for (int u = F.tid; u < (LDS_BYTES - LDSCTL_OFF) / 4; u += NWAVES * 64) ((LAS unsigned*)(F.lds + LDSCTL_OFF))[u] = 0u;
    __syncthreads();
    unsigned* ctl = (unsigned*)(F.ws + WS_CTL);
    XcdBarrier bar = xcd_barrier_post(ctl + CW_BAR + args.li * XCD_BAR_WORDS, F.MISC + 8);
    const int lo = args.ph_lo, hi = args.ph_hi;
#define IN(k) (lo <= (k) && (k) < hi)
#define BOTH(k) (IN(k) && IN((k) + 1))
    if (IN(0)) { p0_prologue(F); if (BOTH(0)) xcd_barrier(bar); }
    if (IN(1)) { p1_norm(F); if (BOTH(1)) xcd_barrier(bar); }
    if (IN(2)) {
        pg8::Gemm g{(const bf16_t*)(F.ws + WS_H), (const bf16_t*)(F.ws + WS_WTIN), T_, NP, D_};
        pg8::StaticOrder S; S.init(T_, NP, F.G, (int)blockIdx.x);
        pg8::EpiProj E{(bf16_t*)(F.ws + WS_PROJ), NP, OQB / 256, OKB / 256, QSCALE};
        pg8::gemm_phase<pg8::EpiProj, pg8::StaticOrder, true, true>(F.lds, g, S, E);
        if (BOTH(2)) xcd_barrier(bar);
    }
    if (IN(5)) {
        pg8::Gemm g{(const bf16_t*)(F.ws + WS_H), (const bf16_t*)(F.ws + WS_WTOUT), T_, D_, D_};
        pg8::StaticOrder S; S.init(T_, D_, F.G, (int)blockIdx.x);
        pg8::EpiOut E{F.x, (const float*)(F.ws + WS_ADA), F.out, (float*)(F.ws + WS_ROWSS)};
        pg8::gemm_phase<pg8::EpiOut, pg8::StaticOrder, true, true>(F.lds, g, S, E);
        if (BOTH(5)) xcd_barrier(bar);
    }
    if (IN(6)) { p6_final(F); }
#undef IN
#undef BOTH
}

template <int MODE>
__global__ void __launch_bounds__(256) k_gemm_naive(const bf16_t* __restrict__ A, const float* __restrict__ W,
                                                    bf16_t* __restrict__ Cb, float* __restrict__ Cf, int N, int ldw) {
  __shared__ float As[16][65];
  __shared__ float Bs[16][65];
  int tx = threadIdx.x & 15, ty = threadIdx.x >> 4;
  int m0 = blockIdx.y * 64, n0 = blockIdx.x * 64;
  float acc[4][4];
  for (int i = 0; i < 4; ++i) for (int j = 0; j < 4; ++j) acc[i][j] = 0.f;
  for (int k0 = 0; k0 < 1024; k0 += 16) {
    for (int e = threadIdx.x; e < 1024; e += 256) {
      int kk = e & 15, mm = e >> 4;
      As[kk][mm] = bf2f(A[(size_t)(m0 + mm) * 1024 + k0 + kk]);
      int nn = e & 63, k2 = e >> 6;
      int n = n0 + nn;
      float wv = 0.f;
      if (n < N) {
        int oc = (MODE == 0) ? orig_col(n) : n;
        wv = W[(size_t)(k0 + k2) * ldw + oc];
      }
      Bs[k2][nn] = wv;
    }
    __syncthreads();
    for (int kk = 0; kk < 16; ++kk) {
      float a[4], bb[4];
      for (int i = 0; i < 4; ++i) a[i] = As[kk][ty * 4 + i];
      for (int j = 0; j < 4; ++j) bb[j] = Bs[kk][tx * 4 + j];
      for (int i = 0; i < 4; ++i) for (int j = 0; j < 4; ++j) acc[i][j] += a[i] * bb[j];
    }
    __syncthreads();
  }
  for (int i = 0; i < 4; ++i) for (int j = 0; j < 4; ++j) {
    int m = m0 + ty * 4 + i, n = n0 + tx * 4 + j;
    if (n >= N) continue;
    if (MODE == 0) {
      if (n < NP) Cb[(size_t)m * NP + n] = f2bf(acc[i][j]);
      else Cf[(size_t)m * 8 + (n - NP)] = acc[i][j];
    } else {
      Cf[(size_t)m * 1024 + n] = acc[i][j];
    }
  }
}

__global__ void __launch_bounds__(256) k_conv(const bf16_t* __restrict__ proj, const float* __restrict__ conv_w,
                                              const float* __restrict__ conv_b, bf16_t* __restrict__ qkc) {
  int t = blockIdx.x;
  int s = t % S_;
  for (int ch = threadIdx.x; ch < 1024; ch += 256) {
    float acc = conv_b[ch];
    for (int tap = 0; tap < 4; ++tap) {
      int ss = s - 3 + tap;
      if (ss >= 0) acc += bf2f(proj[(size_t)(t - 3 + tap) * NP + ch]) * conv_w[tap * 1024 + ch];
    }
    float v = siluf(acc);
    if (ch >= 512) v *= 0.08838834764831845f;
    qkc[(size_t)t * 1024 + ch] = f2bf(v);
  }
}

__global__ void __launch_bounds__(256) k_cloc(const bf16_t* __restrict__ proj, const bf16_t* __restrict__ qkc,
                                              const float* __restrict__ gates, const float* __restrict__ b_i,
                                              const float* __restrict__ b_f, float* __restrict__ Cst,
                                              float* __restrict__ nst, float* __restrict__ amax, float* __restrict__ ftot) {
  __shared__ float logf_[64], cumf[64], a_[64], w_[64];
  __shared__ float ks[64][129];
  int bhc = blockIdx.x;
  int c = bhc & 31, h = (bhc >> 5) & 3, b = bhc >> 7;
  int t0 = b * S_ + c * 64;
  int tid = threadIdx.x;
  if (tid < 64) {
    float fp = gates[(size_t)(t0 + tid) * 8 + 4 + h] + b_f[h];
    float lf = (fp > 0.f) ? -log1pf(__expf(-fp)) : (fp - log1pf(__expf(fp)));
    logf_[tid] = lf;
  }
  for (int e = tid; e < 64 * 128; e += 256) {
    int s = e >> 7, k = e & 127;
    ks[s][k] = bf2f(qkc[(size_t)(t0 + s) * 1024 + 512 + h * 128 + k]);
  }
  __syncthreads();
  if (tid == 0) {
    float cs = 0.f;
    for (int s = 0; s < 64; ++s) { cs += logf_[s]; cumf[s] = cs; }
  }
  __syncthreads();
  if (tid < 64) {
    float ip = gates[(size_t)(t0 + tid) * 8 + h] + b_i[h];
    a_[tid] = cumf[63] - cumf[tid] + ip;
  }
  __syncthreads();
  if (tid == 0) {
    float m = a_[0];
    for (int s = 1; s < 64; ++s) m = fmaxf(m, a_[s]);
    amax[bhc] = m; ftot[bhc] = cumf[63];
    logf_[0] = m;
  }
  __syncthreads();
  if (tid < 64) w_[tid] = __expf(a_[tid] - logf_[0]);
  __syncthreads();
  int k = tid & 127;
  for (int v = (tid >> 7); v < 128; v += 2) {
    float acc = 0.f;
    for (int s = 0; s < 64; ++s) {
      float vv = bf2f(proj[(size_t)(t0 + s) * NP + OVM + h * 128 + v]);
      acc += w_[s] * vv * ks[s][k];
    }
    Cst[(size_t)bhc * 16384 + v * 128 + k] = acc;
  }
  if (tid < 128) {
    float acc = 0.f;
    for (int s = 0; s < 64; ++s) acc += w_[s] * ks[s][tid];
    nst[(size_t)bhc * 128 + tid] = acc;
  }
}

__global__ void __launch_bounds__(256) k_scan(float* __restrict__ Cst, float* __restrict__ nst,
                                              const float* __restrict__ amax, const float* __restrict__ ftot,
                                              float* __restrict__ mprev) {
  int bh = blockIdx.y;
  int e = blockIdx.x * 256 + threadIdx.x;
  if (e >= 16384 + 128) return;
  float st = 0.f, m = 0.f;
  for (int c = 0; c < 32; ++c) {
    int bhc = bh * 32 + c;
    float am = amax[bhc], ft = ftot[bhc];
    float mn = fmaxf(ft + m, am);
    float so = __expf(ft + m - mn), sn = __expf(am - mn);
    float* p = (e < 16384) ? (Cst + (size_t)bhc * 16384 + e) : (nst + (size_t)bhc * 128 + (e - 16384));
    float loc = *p;
    *p = st;
    if (e == 0) mprev[bhc] = m;
    st = so * st + sn * loc;
    m = mn;
  }
}

__global__ void __launch_bounds__(256) k_mout(const bf16_t* __restrict__ proj, const bf16_t* __restrict__ qkc,
                                              const float* __restrict__ gates, const float* __restrict__ b_i,
                                              const float* __restrict__ b_f, const float* __restrict__ Cst,
                                              const float* __restrict__ nst, const float* __restrict__ mprev,
                                              const float* __restrict__ g_head, bf16_t* __restrict__ mix) {
  __shared__ float logf_[64], cumf[64], logi[64], mt[64], isc[64], den[64], rn[64];
  __shared__ float Sm[64][65];
  __shared__ float hs[64][129];
  int bhc = blockIdx.x;
  int c = bhc & 31, h = (bhc >> 5) & 3, b = bhc >> 7;
  int t0 = b * S_ + c * 64;
  int tid = threadIdx.x;
  float mp = mprev[bhc];
  if (tid < 64) {
    float fp = gates[(size_t)(t0 + tid) * 8 + 4 + h] + b_f[h];
    float lf = (fp > 0.f) ? -log1pf(__expf(-fp)) : (fp - log1pf(__expf(fp)));
    logf_[tid] = lf;
    logi[tid] = gates[(size_t)(t0 + tid) * 8 + h] + b_i[h];
  }
  __syncthreads();
  if (tid == 0) {
    float cs = 0.f;
    for (int s = 0; s < 64; ++s) { cs += logf_[s]; cumf[s] = cs; }
  }
  __syncthreads();
  if (tid < 64) {
    int t = tid;
    float mi = cumf[t] + mp;
    float mx = -INFINITY;
    for (int s = 0; s <= t; ++s) mx = fmaxf(mx, cumf[t] - cumf[s] + logi[s]);
    float m = fmaxf(mi, mx);
    mt[t] = m;
    isc[t] = __expf(mi - m);
  }
  __syncthreads();
  const bf16_t* qb = qkc + (size_t)t0 * 1024 + h * 128;
  const bf16_t* kb = qkc + (size_t)t0 * 1024 + 512 + h * 128;
  for (int e = tid; e < 4096; e += 256) {
    int t = e >> 6, s = e & 63;
    float val = 0.f;
    if (s <= t) {
      float dot = 0.f;
      for (int k = 0; k < 128; ++k) dot += bf2f(qb[(size_t)t * 1024 + k]) * bf2f(kb[(size_t)s * 1024 + k]);
      val = dot * __expf(cumf[t] - cumf[s] + logi[s] - mt[t]);
    }
    Sm[t][s] = val;
  }
  __syncthreads();
  if (tid < 64) {
    int t = tid;
    float d = 0.f;
    for (int s = 0; s < 64; ++s) d += Sm[t][s];
    float nq = 0.f;
    for (int k = 0; k < 128; ++k) nq += nst[(size_t)bhc * 128 + k] * bf2f(qb[(size_t)t * 1024 + k]);
    d += isc[t] * nq;
    den[t] = fmaxf(fabsf(d), __expf(-mt[t]));
  }
  __syncthreads();
  for (int e = tid; e < 64 * 128; e += 256) {
    int t = e >> 7, v = e & 127;
    float acc = 0.f;
    for (int s = 0; s <= t; ++s) acc += Sm[t][s] * bf2f(proj[(size_t)(t0 + s) * NP + OVM + h * 128 + v]);
    float cq = 0.f;
    for (int k = 0; k < 128; ++k) cq += Cst[(size_t)bhc * 16384 + v * 128 + k] * bf2f(qb[(size_t)t * 1024 + k]);
    acc += isc[t] * cq;
    hs[t][v] = acc / den[t];
  }
  __syncthreads();
  if (tid < 64) {
    float ss = 0.f;
    for (int v = 0; v < 128; ++v) ss += hs[tid][v] * hs[tid][v];
    rn[tid] = rsqrtf(ss * (1.0f / 128.0f) + 1e-6f);
  }
  __syncthreads();
  for (int e = tid; e < 64 * 128; e += 256) {
    int t = e >> 7, v = e & 127;
    float hm = hs[t][v] * rn[t] * g_head[h * 128 + v];
    float om = bf2f(proj[(size_t)(t0 + t) * NP + OOM + h * 128 + v]);
    float zm = bf2f(proj[(size_t)(t0 + t) * NP + OZM + h * 128 + v]);
    mix[(size_t)(t0 + t) * 1024 + h * 128 + v] = f2bf(hm * sigmoidf_(om) * siluf(zm));
  }
}

__global__ void __launch_bounds__(64) k_kmean(const bf16_t* __restrict__ proj, float* __restrict__ kmean) {
  int bhn = blockIdx.x;
  int n = bhn & 7, h = (bhn >> 3) & 7, b = bhn >> 6;
  int d = threadIdx.x;
  float acc = 0.f;
  for (int s = 0; s < 256; ++s) acc += bf2f(proj[(size_t)(b * S_ + n * 256 + s) * NP + OKB + h * 64 + d]);
  kmean[(size_t)bhn * 64 + d] = acc * (1.0f / 256.0f);
}

__global__ void __launch_bounds__(64) k_moba(const bf16_t* __restrict__ proj, const float* __restrict__ kmean,
                                             bf16_t* __restrict__ mix) {
  int t = blockIdx.x * 64 + threadIdx.x;
  int h = blockIdx.y;
  int b = t / S_, s = t % S_;
  int j = s >> 8;
  float slope = exp2f(-(float)(h + 1));
  float q[64], o[64];
#pragma unroll
  for (int d = 0; d < 64; ++d) { q[d] = bf2f(proj[(size_t)t * NP + OQB + h * 64 + d]); o[d] = 0.f; }
  unsigned selmask = 0;
  if (j <= 3) {
    selmask = (1u << j) - 1u;
  } else {
    float gv[8];
#pragma unroll
    for (int n = 0; n < 8; ++n) {
      float acc = 0.f;
      if (n < j) {
#pragma unroll
        for (int d = 0; d < 64; ++d) acc += q[d] * kmean[(size_t)((b * 8 + h) * 8 + n) * 64 + d];
      } else acc = -INFINITY;
      gv[n] = acc;
    }
    for (int r = 0; r < 3; ++r) {
      float best = -INFINITY; int bi = -1;
#pragma unroll
      for (int n = 0; n < 8; ++n) {
        bool ok = !((selmask >> n) & 1u) && (n < j);
        if (ok && (gv[n] > best || bi < 0)) { best = gv[n]; bi = n; }
      }
      selmask |= (1u << bi);
    }
  }
  float m = -INFINITY, l = 0.f;
  for (int n = 0; n <= j; ++n) {
    bool sel = (n == j) || ((selmask >> n) & 1u);
    if (!sel) continue;
    int kend = (n == j) ? (s - j * 256 + 1) : 256;
    for (int kk = 0; kk < kend; ++kk) {
      int pk = n * 256 + kk;
      const bf16_t* kr = proj + (size_t)(b * S_ + pk) * NP + OKB + h * 64;
      float dot = 0.f;
#pragma unroll
      for (int d = 0; d < 64; ++d) dot += q[d] * bf2f(kr[d]);
      float sc = dot * 0.6931471805599453f - slope * (float)(s - pk);
      float mn = fmaxf(m, sc);
      float corr = __expf(m - mn);
      float p = __expf(sc - mn);
      l = l * corr + p;
      const bf16_t* vr = proj + (size_t)(b * S_ + pk) * NP + OVB + h * 64;
#pragma unroll
      for (int d = 0; d < 64; ++d) o[d] = o[d] * corr + p * bf2f(vr[d]);
      m = mn;
    }
  }
  float inv = 1.0f / l;
#pragma unroll
  for (int d = 0; d < 64; ++d) {
    float zb = bf2f(proj[(size_t)t * NP + OZB + h * 64 + d]);
    mix[(size_t)t * 1024 + 512 + h * 64 + d] = f2bf(o[d] * inv * siluf(zb));
  }
}

__global__ void __launch_bounds__(256) k_final(const float* __restrict__ x, const float* __restrict__ ada,
                                               const float* __restrict__ gf, float* __restrict__ out) {
  __shared__ float red[4];
  int t = blockIdx.x;
  int b = t / S_;
  float v[4];
  float ss = 0.f;
  for (int i = 0; i < 4; ++i) {
    int k = threadIdx.x + 256 * i;
    v[i] = x[(size_t)t * D_ + k] + ada[b * 3072 + 2048 + k] * out[(size_t)t * D_ + k];
    ss += v[i] * v[i];
  }
  for (int o = 32; o > 0; o >>= 1) ss += __shfl_xor(ss, o);
  if ((threadIdx.x & 63) == 0) red[threadIdx.x >> 6] = ss;
  __syncthreads();
  float tot = red[0] + red[1] + red[2] + red[3];
  float r = rsqrtf(tot * (1.0f / 1024.0f) + 1e-6f);
  for (int i = 0; i < 4; ++i) {
    int k = threadIdx.x + 256 * i;
    out[(size_t)t * D_ + k] = v[i] * r * gf[k];
  }
}


extern "C" void kernel_launch(void* const* d_in, const int* in_sizes, int n_in, void* d_out, int out_size,
                              void* d_ws, size_t ws_size, hipStream_t stream) {
  static int grid = 0;
  if (grid == 0) {
    int dev = 0, cus = 0, per_cu = 0;
    if (hipGetDevice(&dev) != hipSuccess || hipDeviceGetAttribute(&cus, hipDeviceAttributeMultiprocessorCount, dev) != hipSuccess) { grid = -1; return; }
    if (hipFuncSetAttribute((const void*)mk_fwd, hipFuncAttributeMaxDynamicSharedMemorySize, LDS_BYTES) != hipSuccess) { fprintf(stderr, "hipFuncSetAttribute failed\n"); grid = -1; return; }
    if (hipOccupancyMaxActiveBlocksPerMultiprocessor(&per_cu, (const void*)mk_fwd, NWAVES * 64, LDS_BYTES) != hipSuccess || per_cu < 1) { fprintf(stderr, "occupancy query: %d\n", per_cu); per_cu = 1; }
    (void)hipGetLastError();
    grid = cus;
    if (ws_size < WS_END) { fprintf(stderr, "workspace too small: %zu\n", ws_size); grid = -1; return; }
  }
  if (grid < 0) return;
  (void)hipMemsetAsync((char*)d_ws + WS_CTL, 0, CTL_ZERO_BYTES, stream);
  Args a{};
  for (int i = 0; i < 13; ++i) a.in[i] = (const float*)d_in[i];
  a.out = (float*)d_out; a.ws = (unsigned char*)d_ws; a.ph_lo = 0; a.ph_hi = 3; a.li = 0;
  hipLaunchKernelGGL(mk_fwd, dim3(grid), dim3(NWAVES * 64), LDS_BYTES, stream, a);

  const float* x = (const float*)d_in[0];
  const float* conv_w = (const float*)d_in[6];
  const float* conv_b = (const float*)d_in[7];
  const float* b_ig = (const float*)d_in[8];
  const float* b_fg = (const float*)d_in[9];
  const float* g_head = (const float*)d_in[10];
  const float* w_out = (const float*)d_in[11];
  const float* g_final = (const float*)d_in[12];
  float* out = (float*)d_out;
  char* ws = (char*)d_ws;
  bf16_t* proj = (bf16_t*)(ws + WS_PROJ);
  bf16_t* mix = (bf16_t*)(ws + WS_H);
  bf16_t* qkc = (bf16_t*)(ws + WS_QKC);
  float* gates = (float*)(ws + WS_GATES);
  float* ada = (float*)(ws + WS_ADA);
  float* kmean = (float*)(ws + WS_KMEAN);
  float* nst = (float*)(ws + WS_SMALL);
  float* amax = nst + 1024 * 128;
  float* ftot = amax + 1024;
  float* mprev = ftot + 1024;
  float* Cst = (float*)d_out;
  k_conv<<<T_, 256, 0, stream>>>(proj, conv_w, conv_b, qkc);
  k_cloc<<<1024, 256, 0, stream>>>(proj, qkc, gates, b_ig, b_fg, Cst, nst, amax, ftot);
  k_scan<<<dim3((16384 + 128 + 255) / 256, 32), 256, 0, stream>>>(Cst, nst, amax, ftot, mprev);
  k_mout<<<1024, 256, 0, stream>>>(proj, qkc, gates, b_ig, b_fg, Cst, nst, mprev, g_head, mix);
  k_kmean<<<512, 64, 0, stream>>>(proj, kmean);
  k_moba<<<dim3(T_ / 64, 8), 64, 0, stream>>>(proj, kmean, mix);
  a.ph_lo = 5; a.ph_hi = 7; a.li = 1;
  hipLaunchKernelGGL(mk_fwd, dim3(grid), dim3(NWAVES * 64), LDS_BYTES, stream, a);
}
```

```cpp
#include <hip/hip_runtime.h>
#include <cstdio>
#include <cstdint>

#define B_ 8
#define S_ 2048
#define D_ 1024
#define T_ (B_ * S_)
#define NP 4608
#define NPROJ 4616
#define OQM 0
#define OKM 512
#define OVM 1024
#define OOM 1536
#define OZM 2048
#define OQB 2560
#define OKB 3072
#define OVB 3584
#define OZB 4096
#define NKS 16

typedef unsigned short bf16_t;
namespace pg8 {
#define PG8_LAS __attribute__((address_space(3)))
typedef unsigned short bf16_t;
typedef short bf16x8 __attribute__((ext_vector_type(8)));
typedef float f32x4 __attribute__((ext_vector_type(4)));
typedef unsigned u32x4 __attribute__((ext_vector_type(4)));
constexpr int BM = 256, BK = 64, HALF = 128, HTB = HALF * BK * 2  , STAGE_BYTES = 8 * HTB, NXCD = 8, WGM = 8;

__host__ __device__ __forceinline__ int lds_byte(int r, int c) { const int st = (r >> 4) * 2 + (c >> 5), rr = r & 15, cc = c & 31, ob = rr * 64 + cc * 2; return st * 1024 + (ob ^ (((ob >> 9) & 1) << 5)); }
__host__ __device__ __forceinline__ void stage_rc(int b, int& R, int& C) { const int st = b / 1024, sb = b % 1024, swz = sb ^ (((sb >> 9) & 1) << 5); R = (st >> 1) * 16 + swz / 64; C = (st & 1) * 32 + (swz % 64) / 2; }
__host__ __device__ __forceinline__ int perm32(int rho) { const int n = rho >> 4, i = rho & 15; return 8 * (i >> 2) + 4 * n + (i & 3); }

struct Unit { int pm, pn; };
struct Gemm { const bf16_t* A; const bf16_t* Bt; int M, N, K; };

struct StaticOrder {
    int nM, nN, nwg, G, c;
    __host__ __device__ void init(int M, int N, int G_, int c_) { nM = M / BM; nN = N / BM; nwg = nM * nN; G = G_; c = c_; }
    __host__ __device__ bool next(int i, Unit& u) const {
        const long L = (long)i * G + c; if (L >= nwg) return false;
        int wgid = (int)L; { const int q = nwg / NXCD, r = nwg % NXCD, xcd = wgid % NXCD, off = wgid / NXCD; wgid = (xcd < r ? xcd * (q + 1) : r * (q + 1) + (xcd - r) * q) + off; }
        const int nig = WGM * nN, gid = wgid / nig, fm = gid * WGM, gsz = (nM - fm) < WGM ? (nM - fm) : WGM;
        u.pm = fm + ((wgid % nig) % gsz); u.pn = (wgid % nig) / gsz; return true;
    }
    __device__ __forceinline__ void a_ready(const Unit&) const {}
    __device__ __forceinline__ void done(const Unit&) const {}
};

__device__ __forceinline__ unsigned cvt_pk_bf16(float lo, float hi) { unsigned r; asm volatile("v_cvt_pk_bf16_f32 %0, %1, %2" : "=v"(r) : "v"(lo), "v"(hi)); return r; }

struct EpiProj {
    static constexpr bool PERM = true, AFTER_DRAIN = false;
    bf16_t* O; int ldc; int qt_lo, qt_hi; float qscale;
    __device__ __forceinline__ void operator()(const f32x4 (&acc)[2][2][4][2], const Unit& u, int wr, int wc, int fr, int fq) const {
        const int row0 = u.pm * BM + wr * 64 + fr; const int col0 = u.pn * BM + wc * 32 + 8 * fq;
        const float sc = (u.pn >= qt_lo && u.pn < qt_hi) ? qscale : 1.f;
#pragma unroll
        for (int ai = 0; ai < 2; ++ai)
#pragma unroll
            for (int m = 0; m < 4; ++m) { bf16_t* rowp = O + (size_t)(row0 + ai * HALF + m * 16) * ldc + col0;
#pragma unroll
                for (int bj = 0; bj < 2; ++bj) { f32x4 v0 = acc[ai][bj][m][0] * sc, v1 = acc[ai][bj][m][1] * sc;
                    u32x4 w; w.x = cvt_pk_bf16(v0[0], v0[1]); w.y = cvt_pk_bf16(v0[2], v0[3]); w.z = cvt_pk_bf16(v1[0], v1[1]); w.w = cvt_pk_bf16(v1[2], v1[3]);
                    *(u32x4*)(rowp + bj * HALF) = w; } }
    }
};
struct EpiOut {
    static constexpr bool PERM = false, AFTER_DRAIN = false;
    const float* X; const float* gate; float* XN; float* rowss;
    __device__ __forceinline__ void operator()(const f32x4 (&acc)[2][2][4][2], const Unit& u, int wr, int wc, int fr, int fq) const {
        const int row0 = u.pm * BM + wr * 64 + fr, col0 = u.pn * BM + wc * 32 + 4 * fq;
        const float* gb = gate + (size_t)((u.pm * BM) / 2048) * 3072 + 2048;
        f32x4 gv[2][2];
#pragma unroll
        for (int bj = 0; bj < 2; ++bj)
#pragma unroll
            for (int n = 0; n < 2; ++n) gv[bj][n] = *(const f32x4*)(gb + col0 + bj * HALF + n * 16);
#pragma unroll
        for (int ai = 0; ai < 2; ++ai)
#pragma unroll
            for (int m = 0; m < 4; ++m) { const size_t ro = (size_t)(row0 + ai * HALF + m * 16) * 1024 + col0; float ss = 0.f;
#pragma unroll
                for (int bj = 0; bj < 2; ++bj)
#pragma unroll
                    for (int n = 0; n < 2; ++n) { const f32x4 xv = *(const f32x4*)(X + ro + bj * HALF + n * 16); const f32x4 r = xv + gv[bj][n] * acc[ai][bj][m][n];
                        ss += r[0] * r[0] + r[1] * r[1] + r[2] * r[2] + r[3] * r[3]; *(f32x4*)(XN + ro + bj * HALF + n * 16) = r; }
                ss += __shfl_xor(ss, 16); ss += __shfl_xor(ss, 32);
                if (fq == 0) rowss[((size_t)(row0 + ai * HALF + m * 16) * 4 + u.pn) * 4 + wc] = ss; }
    }
};
template <class Epi, class Sched, bool ALIGN_EPI = false, bool SP2 = false>
__device__ __forceinline__ void gemm_phase(PG8_LAS unsigned char* lds, const Gemm g, const Sched& S, const Epi& E) {
    const int tid = threadIdx.x, wid = __builtin_amdgcn_readfirstlane(tid >> 6), lane = tid & 63, wr = wid >> 2, wc = wid & 3, fr = lane & 15, fq = lane >> 4;
    const int K = g.K, nt = K / BK;
    unsigned voffA[2], voffB[2];
#pragma unroll
    for (int i = 0; i < 2; ++i) { int R, C; stage_rc(tid * 16 + i * 8192, R, C); const int Rb = Epi::PERM ? ((R & ~31) + perm32(R & 31)) : R;
        voffA[i] = (unsigned)(R * K + C) * 2u; voffB[i] = (unsigned)(Rb * K + C) * 2u; }
    const size_t kstep = (size_t)(BK * 2);
    const size_t hstep = (size_t)HALF * K * 2;
    const size_t tstep = 2 * hstep;
    const unsigned ldsw = (unsigned)wid * 1024u;
    const int aoff = lds_byte(wr * 64 + fr, fq * 8), boff = lds_byte(wc * 32 + fr, fq * 8);
#define PG8_SA(b, h) (((b) * 2 + (h)) * HTB)
#define PG8_SB(b, h) ((4 + (b) * 2 + (h)) * HTB)
#define PG8_STAGE(bufoff, gbase, voff) do { _Pragma("unroll") for (int _i = 0; _i < 2; ++_i) \
        __builtin_amdgcn_global_load_lds((const unsigned*)((const char*)(gbase) + (voff)[_i]), (PG8_LAS unsigned*)(lds + (bufoff) + ldsw + _i * 8192), 16, 0, 0); } while (0)
#define PG8_LDA(dst, b, h) do { _Pragma("unroll") for (int m = 0; m < 4; ++m) _Pragma("unroll") for (int k = 0; k < 2; ++k) dst[m][k] = *(const PG8_LAS bf16x8*)(lds + PG8_SA(b, h) + aoff + m * 2048 + k * 1024); } while (0)
#define PG8_LDB(dst, b, h) do { _Pragma("unroll") for (int n = 0; n < 2; ++n) _Pragma("unroll") for (int k = 0; k < 2; ++k) dst[n][k] = *(const PG8_LAS bf16x8*)(lds + PG8_SB(b, h) + boff + n * 2048 + k * 1024); } while (0)
#define PG8_MMA(ai, bj, At, Bt) do { __builtin_amdgcn_s_setprio(1); _Pragma("unroll") for (int m = 0; m < 4; ++m) _Pragma("unroll") for (int n = 0; n < 2; ++n) _Pragma("unroll") for (int k = 0; k < 2; ++k) \
        acc[ai][bj][m][n] = __builtin_amdgcn_mfma_f32_16x16x32_bf16(Bt[n][k], At[m][k], acc[ai][bj][m][n], 0, 0, 0); __builtin_amdgcn_s_setprio(0); } while (0)
#define PG8_WAIT_V(n) asm volatile("s_waitcnt vmcnt(" #n ")" ::: "memory")
#define PG8_WAIT_L(n) asm volatile("s_waitcnt lgkmcnt(" #n ")" ::: "memory")
#define PG8_BAR __builtin_amdgcn_s_barrier()
#define PG8_SCHED __builtin_amdgcn_sched_barrier(0)
    Unit cur, nxt; int ui = 0;
    if (!S.next(0, cur)) return;
    f32x4 acc[2][2][4][2];
#pragma unroll
    for (int a = 0; a < 2; ++a)
#pragma unroll
        for (int b = 0; b < 2; ++b)
#pragma unroll
            for (int m = 0; m < 4; ++m)
#pragma unroll
                for (int n = 0; n < 2; ++n) acc[a][b][m][n] = (f32x4){0.f, 0.f, 0.f, 0.f};
    bf16x8 At[4][2], B0[2][2], B1[2][2];
    const char* cA = (const char*)g.A + (size_t)cur.pm * tstep; const char* cB = (const char*)g.Bt + (size_t)cur.pn * tstep;
    S.a_ready(cur);
    if constexpr (SP2) {
        PG8_STAGE(PG8_SB(0, 0), cB, voffB); PG8_STAGE(PG8_SB(0, 1), cB + hstep, voffB); PG8_STAGE(PG8_SA(0, 0), cA, voffA); PG8_STAGE(PG8_SA(0, 1), cA + hstep, voffA);
        if (wr == 1) PG8_BAR;
        PG8_WAIT_V(2); PG8_BAR;
        PG8_STAGE(PG8_SB(1, 0), cB + kstep, voffB); PG8_STAGE(PG8_SA(1, 0), cA + kstep, voffA); PG8_STAGE(PG8_SB(1, 1), cB + hstep + kstep, voffB);
        PG8_WAIT_V(6); PG8_BAR;
    } else {
        PG8_STAGE(PG8_SB(0, 0), cB, voffB); PG8_STAGE(PG8_SA(0, 0), cA, voffA); PG8_STAGE(PG8_SB(0, 1), cB + hstep, voffB); PG8_STAGE(PG8_SA(0, 1), cA + hstep, voffA);
        if (wr == 1) PG8_BAR;
        PG8_WAIT_V(4); PG8_BAR;
        PG8_STAGE(PG8_SB(1, 0), cB + kstep, voffB); PG8_STAGE(PG8_SA(1, 0), cA + kstep, voffA); PG8_STAGE(PG8_SB(1, 1), cB + hstep + kstep, voffB);
        PG8_WAIT_V(6); PG8_BAR;
    }
    for (;;) {
        const bool has_next = S.next(ui + 1, nxt);
        const char* nA = has_next ? (const char*)g.A + (size_t)nxt.pm * tstep : cA; const char* nB = has_next ? (const char*)g.Bt + (size_t)nxt.pn * tstep : cB;
        for (int t = 0; t < nt; t += 2) {
            const bool last = (t == nt - 2);
            const char* a1 = cA + (size_t)(t + 1) * kstep;
            const char* a2 = last ? nA : cA + (size_t)(t + 2) * kstep; const char* b2 = last ? nB : cB + (size_t)(t + 2) * kstep;
            const char* a3 = a2 + kstep; const char* b3 = b2 + kstep;
            if (last && has_next) S.a_ready(nxt);
            if constexpr (SP2) {
            PG8_LDB(B0, 0, 0); PG8_LDB(B1, 0, 1); PG8_SCHED; PG8_LDA(At, 0, 0); PG8_STAGE(PG8_SA(1, 1), a1 + hstep, voffA);
            PG8_WAIT_V(8); PG8_WAIT_L(0); PG8_BAR; PG8_MMA(0, 0, At, B0); PG8_MMA(0, 1, At, B1); PG8_BAR; PG8_SCHED;
            PG8_LDA(At, 0, 1); PG8_STAGE(PG8_SB(0, 0), b2, voffB); PG8_STAGE(PG8_SB(0, 1), b2 + hstep, voffB); PG8_STAGE(PG8_SA(0, 0), a2, voffA);
            PG8_WAIT_V(8); PG8_WAIT_L(0); PG8_BAR; PG8_MMA(1, 0, At, B0); PG8_MMA(1, 1, At, B1); PG8_BAR; PG8_SCHED;
            PG8_LDB(B0, 1, 0); PG8_LDB(B1, 1, 1); PG8_SCHED; PG8_LDA(At, 1, 0); PG8_STAGE(PG8_SA(0, 1), a2 + hstep, voffA);
            PG8_WAIT_V(8); PG8_WAIT_L(0); PG8_BAR; PG8_MMA(0, 0, At, B0); PG8_MMA(0, 1, At, B1); PG8_BAR; PG8_SCHED;
            PG8_LDA(At, 1, 1); PG8_STAGE(PG8_SB(1, 0), b3, voffB); PG8_STAGE(PG8_SB(1, 1), b3 + hstep, voffB); PG8_STAGE(PG8_SA(1, 0), a3, voffA);
            PG8_WAIT_V(8); PG8_WAIT_L(0); PG8_BAR; PG8_MMA(1, 0, At, B0); PG8_MMA(1, 1, At, B1); PG8_BAR; PG8_SCHED;
            } else {
            PG8_LDB(B0, 0, 0); PG8_SCHED; PG8_LDA(At, 0, 0); PG8_STAGE(PG8_SA(1, 1), a1 + hstep, voffA);
            PG8_WAIT_L(8); PG8_BAR; PG8_WAIT_L(0); PG8_MMA(0, 0, At, B0); PG8_BAR; PG8_SCHED;
            PG8_LDB(B1, 0, 1); PG8_STAGE(PG8_SB(0, 0), b2, voffB);
            PG8_BAR; PG8_WAIT_L(0); PG8_MMA(0, 1, At, B1); PG8_BAR;
            PG8_LDA(At, 0, 1); PG8_STAGE(PG8_SA(0, 0), a2, voffA);
            PG8_BAR; PG8_WAIT_L(0); PG8_MMA(1, 0, At, B0); PG8_BAR; PG8_SCHED;
            PG8_STAGE(PG8_SB(0, 1), b2 + hstep, voffB);
            PG8_WAIT_V(6); PG8_BAR; PG8_MMA(1, 1, At, B1); PG8_BAR;
            PG8_LDB(B0, 1, 0); PG8_SCHED; PG8_LDA(At, 1, 0); PG8_STAGE(PG8_SA(0, 1), a2 + hstep, voffA);
            PG8_WAIT_L(8); PG8_BAR; PG8_WAIT_L(0); PG8_MMA(0, 0, At, B0); PG8_BAR; PG8_SCHED;
            PG8_LDB(B1, 1, 1); PG8_STAGE(PG8_SB(1, 0), b3, voffB);
            PG8_BAR; PG8_WAIT_L(0); PG8_MMA(0, 1, At, B1); PG8_BAR;
            PG8_LDA(At, 1, 1); PG8_STAGE(PG8_SA(1, 0), a3, voffA);
            PG8_BAR; PG8_WAIT_L(0); PG8_MMA(1, 0, At, B0); PG8_BAR; PG8_SCHED;
            PG8_STAGE(PG8_SB(1, 1), b3 + hstep, voffB);
            PG8_WAIT_V(6); PG8_BAR; PG8_MMA(1, 1, At, B1); PG8_BAR;
            }
        }
        if constexpr (ALIGN_EPI) { if (wr == 0) PG8_BAR; }
        if constexpr (!Epi::AFTER_DRAIN) { E(acc, cur, wr, wc, fr, fq); S.done(cur); }
        if (!has_next) break;
#pragma unroll
        for (int a = 0; a < 2; ++a)
#pragma unroll
            for (int b = 0; b < 2; ++b)
#pragma unroll
                for (int m = 0; m < 4; ++m)
#pragma unroll
                    for (int n = 0; n < 2; ++n) acc[a][b][m][n] = (f32x4){0.f, 0.f, 0.f, 0.f};
        cur = nxt; cA = nA; cB = nB; ++ui;
        if constexpr (ALIGN_EPI) { if (wr == 1) PG8_BAR; }
    }
    PG8_WAIT_V(0);
    if constexpr (!ALIGN_EPI) { if (wr == 0) PG8_BAR; }
    PG8_BAR;
    if constexpr (Epi::AFTER_DRAIN) { E.fused(acc, cur, wr, wc, fr, fq, lds, wid, lane); S.done(cur); }
#undef PG8_SA
#undef PG8_SB
#undef PG8_STAGE
#undef PG8_LDA
#undef PG8_LDB
#undef PG8_MMA
#undef PG8_WAIT_V
#undef PG8_WAIT_L
#undef PG8_BAR
#undef PG8_SCHED
}
}
#include <hip/hip_bf16.h>
#include <cmath>
namespace moba_body {
using bf16=__hip_bfloat16;
using bf16x8=__attribute__((ext_vector_type(8)))short;
using s16x4=__attribute__((ext_vector_type(4)))short;
using f32x16=__attribute__((ext_vector_type(16)))float;
using u32x4=__attribute__((ext_vector_type(4)))unsigned;
using f32x4_t=__attribute__((ext_vector_type(4)))float;
constexpr int BATCH=8,NHEAD=8,SEQ=2048,D=64,DM=4608,DMO=1024;
constexpr int NW=8,QBLK=32,QB=QBLK*NW,KVBLK=64,NQB=SEQ/QB;
constexpr int ATTN_PITCH=DM, ATTN_UNIT_ROWS=QB;
__device__ __forceinline__ int crow(int r,int hi){return (r&3)+8*(r>>2)+4*hi;}
#define SBAR() __builtin_amdgcn_sched_barrier(0)
__device__ __forceinline__ void cmask(f32x16&p0,f32x16&p1,int jb,int qrel,int hi){
  const float NEG=-INFINITY; int kb=64*jb+4*hi;
  #pragma unroll
  for(int r=0;r<16;++r){int kv=kb+(r&3)+8*(r>>2); if(kv>qrel)p0[r]=NEG; if(kv+32>qrel)p1[r]=NEG;}
}

constexpr int NSLOT=3, SLOTB=8192;
constexpr int LDS_K=0, LDS_V=NSLOT*SLOTB, LDS_WS=2*NSLOT*SLOTB, LDS_OST=LDS_WS+NW*64*4, LDS_BYTES=LDS_OST+NW*4096;
constexpr float C2=0.125f*1.4426950408889634f;
__device__ __forceinline__ void glds16(const void*gsrc,unsigned lds_dst){unsigned keep;
  asm volatile("s_mov_b32 %0, m0\n\ts_mov_b32 m0, %2\n\ts_nop 0\n\tglobal_load_lds_dwordx4 %1, off\n\ts_mov_b32 m0, %0":"=&s"(keep):"v"(gsrc),"s"(lds_dst):"memory");}
__device__ __forceinline__ float max3f(float a,float b,float c){float r;asm("v_max3_f32 %0, %1, %2, %3":"=v"(r):"v"(a),"v"(b),"v"(c));return r;}
__device__ __forceinline__ float max2f(float a,float b){float r;asm("v_max_f32_e32 %0, %1, %2":"=v"(r):"v"(a),"v"(b));return r;}
__device__ __forceinline__ float fadd_s(float a,float b){float r;asm("v_add_f32_e32 %0, %1, %2":"=v"(r):"v"(a),"v"(b));return r;}
__device__ __forceinline__ float fsub_s(float a,float b){float r;asm("v_sub_f32_e32 %0, %1, %2":"=v"(r):"v"(a),"v"(b));return r;}
typedef float f32x2_t __attribute__((ext_vector_type(2))); typedef __bf16 bf16x2_t __attribute__((ext_vector_type(2)));
__device__ __forceinline__ unsigned cvtpk_s(float lo,float hi){f32x2_t v={lo,hi};bf16x2_t b=__builtin_convertvector(v,bf16x2_t);return __builtin_bit_cast(unsigned,b);}
#define WAIT_BAR(N) asm volatile("s_waitcnt vmcnt(" #N ") lgkmcnt(0)\n\ts_barrier":::"memory")

__device__ __forceinline__ void qkt(f32x16&p0,f32x16&p1,const char*Kslot,const bf16x8*qr,const f32x16&negm,int r32,int hi){
  const char*kb=Kslot+hi*1024+r32*16;
  #pragma unroll
  for(int d0=0;d0<4;++d0){
    const bf16x8 b0=*reinterpret_cast<const bf16x8*>(kb+d0*2048);
    const bf16x8 b1=*reinterpret_cast<const bf16x8*>(kb+d0*2048+512);
    if(d0==0){p0=__builtin_amdgcn_mfma_f32_32x32x16_bf16(b0,qr[0],negm,0,0,0);p1=__builtin_amdgcn_mfma_f32_32x32x16_bf16(b1,qr[0],negm,0,0,0);}
    else{p0=__builtin_amdgcn_mfma_f32_32x32x16_bf16(b0,qr[d0],p0,0,0,0);p1=__builtin_amdgcn_mfma_f32_32x32x16_bf16(b1,qr[d0],p1,0,0,0);}}
}
typedef __attribute__((address_space(3))) const char* lds_cptr;
typedef short v4i16_t __attribute__((ext_vector_type(4)));
__device__ __forceinline__ void kload8(bf16x8*kf,lds_cptr kp){
  kf[0]=*(const __attribute__((address_space(3))) bf16x8*)(kp);      kf[1]=*(const __attribute__((address_space(3))) bf16x8*)(kp+512);
  kf[2]=*(const __attribute__((address_space(3))) bf16x8*)(kp+2048); kf[3]=*(const __attribute__((address_space(3))) bf16x8*)(kp+2560);
  kf[4]=*(const __attribute__((address_space(3))) bf16x8*)(kp+4096); kf[5]=*(const __attribute__((address_space(3))) bf16x8*)(kp+4608);
  kf[6]=*(const __attribute__((address_space(3))) bf16x8*)(kp+6144); kf[7]=*(const __attribute__((address_space(3))) bf16x8*)(kp+6656);
}
__device__ __forceinline__ void kload2(bf16x8*kf,lds_cptr kp,int j){ kf[2*j]=*(const __attribute__((address_space(3))) bf16x8*)(kp+j*2048); kf[2*j+1]=*(const __attribute__((address_space(3))) bf16x8*)(kp+j*2048+512); }
__device__ __forceinline__ s16x4 vtr(lds_cptr p){ return __builtin_bit_cast(s16x4,__builtin_amdgcn_ds_read_tr16_b64_v4i16((__attribute__((address_space(3))) v4i16_t*)p)); }
__device__ __forceinline__ float rowmax(const f32x16&p0,const f32x16&p1){
  float a=max3f(p0[0],p0[1],p1[0]),b=max3f(p0[2],p0[3],p1[1]);a=max3f(a,p1[2],p1[3]);
  #pragma unroll
  for(int r=4;r<16;r+=4){a=max3f(a,p0[r],p0[r+1]);b=max3f(b,p0[r+2],p0[r+3]);a=max3f(a,p1[r],p1[r+1]);b=max3f(b,p1[r+2],p1[r+3]);}
  const float m=max2f(a,b);
  auto rr=__builtin_amdgcn_permlane32_swap(__float_as_uint(m),__float_as_uint(m),false,false);
  return max2f(__uint_as_float(rr[0]),__uint_as_float(rr[1]));
}
__device__ __forceinline__ void pv(f32x16*o,int vb,bf16x8 pa0,bf16x8 pa1,bf16x8 pa2,bf16x8 pa3){
  #pragma unroll
  for(int d0=0;d0<2;++d0){s16x4 lo[4],hi[4];
    #pragma unroll
    for(int ks=0;ks<4;++ks){
      asm volatile("ds_read_b64_tr_b16 %0,%1 offset:%c2":"=&v"(lo[ks]):"v"(vb),"i"(d0*4096+ks*1024):"memory");
      asm volatile("ds_read_b64_tr_b16 %0,%1 offset:%c2":"=&v"(hi[ks]):"v"(vb),"i"(d0*4096+ks*1024+512):"memory");}
    asm volatile("s_waitcnt lgkmcnt(0)":::"memory");SBAR();
    #define PK(k) (bf16x8){lo[k][0],lo[k][1],lo[k][2],lo[k][3],hi[k][0],hi[k][1],hi[k][2],hi[k][3]}
    o[d0]=__builtin_amdgcn_mfma_f32_32x32x16_bf16(pa0,PK(0),o[d0],0,0,0);
    o[d0]=__builtin_amdgcn_mfma_f32_32x32x16_bf16(pa1,PK(1),o[d0],0,0,0);
    o[d0]=__builtin_amdgcn_mfma_f32_32x32x16_bf16(pa2,PK(2),o[d0],0,0,0);
    o[d0]=__builtin_amdgcn_mfma_f32_32x32x16_bf16(pa3,PK(3),o[d0],0,0,0);
    #undef PK
  }
}

#ifndef ATTN_STORE16
#define ATTN_STORE16(p,v) (*(u32x4*)(p)=(v))
#endif
template<int THRL> __device__ __forceinline__ void attn_unit(int b,int h,int qb,const bf16*Q,const bf16*__restrict__ K,const bf16*__restrict__ V,const bf16*__restrict__ Z,bf16*O,const float*__restrict__ kmean,char*shm){
  const int tid=threadIdx.x,lane=tid&63,r32=lane&31,hi=lane>>5; const int wid=__builtin_amdgcn_readfirstlane(tid>>6);
  const long rowbase=(long)b*SEQ; const int q0=qb*QB;
  const bf16*Qw=Q+(rowbase+q0+wid*QBLK)*DM+h*D;
  const bf16*Kh=K+rowbase*DM+h*D,*Vh=V+rowbase*DM+h*D;
  const unsigned lds0=(unsigned)(uintptr_t)shm;
  float*wsf=(float*)(shm+LDS_WS)+wid*64;
  const bf16*ksrc=Kh+(long)lane*DM+wid*8;
  const bf16*vsrc=Vh+(long)(16*(wid&3)+(lane>>2))*DM+(wid>>2)*32+(lane&3)*8;
  const unsigned kdst=lds0+LDS_K+wid*1024, vdst=lds0+LDS_V+wid*1024;
  #define DMA_K(t,slot) glds16(ksrc+(long)(t)*KVBLK*DM,(unsigned)__builtin_amdgcn_readfirstlane(kdst+(slot)))
  #define DMA_V(t,slot) glds16(vsrc+(long)(t)*KVBLK*DM,(unsigned)__builtin_amdgcn_readfirstlane(vdst+(slot)))
  const int vb0=(int)(lds0+LDS_V)+((lane>>4)&1)*32+(lane&3)*8+(4*hi+((lane&15)>>2))*64;
  const char*Kbase=shm+LDS_K; bf16x8 kf[8];
  const lds_cptr shm3=(lds_cptr)shm; const lds_cptr kp0=shm3+LDS_K+hi*1024+r32*16; const lds_cptr vp0=shm3+LDS_V+((lane>>4)&1)*32+(lane&3)*8+(4*hi+((lane&15)>>2))*64;
  const int NT=(q0+QB)/KVBLK;
  DMA_K(0,0);DMA_V(0,0);DMA_K(1,SLOTB);
  bf16x8 qr[4];
  #pragma unroll
  for(int d0=0;d0<4;++d0)qr[d0]=*reinterpret_cast<const bf16x8*>(&Qw[(long)r32*DM+d0*16+hi*8]);
  float mhat=0.f,l_reg=0.f;f32x16 o[2];o[0]=f32x16{};o[1]=f32x16{};f32x16 negm;
  const int qrel=wid*QBLK+r32;
  const float slope2=__builtin_amdgcn_exp2f(-(float)(h+1))*1.4426950408889634f;
  unsigned selmask=0xFFu;
  if(qb>=4){
    float g[7];
    #pragma unroll
    for(int n=0;n<7;++n){ float a=-INFINITY;
      if(n<qb){ a=0.f; const float*km=kmean+n*64+hi*8;
        #pragma unroll
        for(int d0=0;d0<4;++d0){ const f32x4_t k0=*(const f32x4_t*)(km+d0*16),k1=*(const f32x4_t*)(km+d0*16+4);
          #pragma unroll
          for(int jj=0;jj<4;++jj){ a+=__uint_as_float(((unsigned)(unsigned short)qr[d0][jj])<<16)*k0[jj]; a+=__uint_as_float(((unsigned)(unsigned short)qr[d0][4+jj])<<16)*k1[jj]; } }
        a+=__shfl_xor(a,32); }
      g[n]=a; }
    unsigned m_=1u<<qb;
    #pragma unroll
    for(int n=0;n<7;++n){ int rank=0;
      #pragma unroll
      for(int mm=0;mm<7;++mm){ if(mm!=n) rank+=((g[mm]>g[n])||(g[mm]==g[n]&&mm<n))?1:0; }
      if(n<qb&&rank<3) m_|=1u<<n; }
    selmask=m_;
  }
  #define NEGM_SET(tt) do{ const float tb_=slope2*(float)(64*(tt)-q0+4*hi); const float mr_=((selmask>>((tt)>>2))&1u)?(tb_-mhat):-INFINITY; \
    _Pragma("unroll") for(int r=0;r<16;++r)negm[r]=__builtin_fmaf(slope2,(float)((r&3)+8*(r>>2)),mr_); asm volatile("":"+v"(negm)); }while(0)
  #define BIAS1(P1) do{ _Pragma("unroll") for(int r=0;r<16;++r)P1[r]+=32.f*slope2; }while(0)
  #define CMASK(P0,P1,t) do{int jb_=(t)-(NT-4); if(jb_>=0)cmask(P0,P1,jb_,qrel,hi);}while(0)
  bool resc=false;
  #define START(P0,P1) do{ const float rm=rowmax(P0,P1); resc=false; \
    { const float dl=(rm==-INFINITY)?0.f:rm; mhat=fadd_s(mhat,dl); \
      _Pragma("unroll") for(int r=0;r<16;++r){P0[r]=fsub_s(P0[r],dl);P1[r]=fsub_s(P1[r],dl);} } \
    _Pragma("unroll") for(int r=0;r<16;++r)P0[r]=__builtin_amdgcn_exp2f(P0[r]); }while(0)
  #define RESC() do{ if(resc){ asm volatile("s_waitcnt lgkmcnt(0)":::"memory"); \
      _Pragma("unroll") for(int d_=0;d_<2;++d_) _Pragma("unroll") for(int r=0;r<16;++r)o[d_][r]*=wsf[crow(r,hi)]; } }while(0)
  f32x16 pA0,pA1,pB0,pB1;
  int sl_prev=0,sl_cur=0,sl_next=SLOTB;
  #define ROT() do{sl_prev=sl_cur;sl_cur=sl_next;sl_next=(sl_next==(NSLOT-1)*SLOTB)?0:sl_next+SLOTB;}while(0)
  DMA_K(2,2*SLOTB);
  WAIT_BAR(3);
  NEGM_SET(0);
  qkt(pA0,pA1,Kbase,qr,negm,r32,hi);asm volatile("s_nop 15\n\ts_nop 7":"+v"(pA0),"+v"(pA1));BIAS1(pA1);CMASK(pA0,pA1,0);
  START(pA0,pA1);
  _Pragma("unroll") for(int r=0;r<16;++r)pA1[r]=__builtin_amdgcn_exp2f(pA1[r]);
  WAIT_BAR(0);
  DMA_K(3,0);DMA_V(1,SLOTB);
  ROT();
  kload8(kf,kp0+sl_cur);
  WAIT_BAR(2);
  s16x4 vlo[8],vhi[8]; u32x4 pw0,pw1,pw2,pw3;
  #define PKW(P,B) cvtpk_s(P[B],P[B+1])
  #define PAF(k) __builtin_bit_cast(bf16x8,pw##k)
  #define VFR(i) (bf16x8){vlo[i][0],vlo[i][1],vlo[i][2],vlo[i][3],vhi[i][0],vhi[i][1],vhi[i][2],vhi[i][3]}
  #define PIN(x) asm volatile("":"+v"(x))
  #define MX3(a,b,c) __builtin_fmaxf(__builtin_fmaxf((a),(b)),(c))
  #define GAPA(MF,A0,A1,A2,A3,W0,W1,PW) do{ MF; sacc+=A0; sacc+=A1; sacc+=A2; sacc+=A3; PIN(sacc); W0; W1; PIN(PW); SBAR(); }while(0)
  #define EX(v) __builtin_amdgcn_exp2f(v)
  #define GAPB(MF,X,B) do{ MF; X[B]=EX(X[B]); X[B+1]=EX(X[B+1]); X[B+2]=EX(X[B+2]); X[B+3]=EX(X[B+3]); PIN(X); SBAR(); }while(0)
  #define VRD(i) do{ vlo[i]=vtr(vp_+(((i)>>2)*4096+((i)&3)*1024)); vhi[i]=vtr(vp_+(((i)>>2)*4096+((i)&3)*1024+512)); }while(0)
  #define KRD(G,j) do{ if(G){ kload2(kf,kp0+sl_next,j); SBAR(); } }while(0)
  #define STEP(C0,C1,P0,P1,t,GK,GV,GL) do{ SBAR(); NEGM_SET(t); SBAR(); \
    const lds_cptr vp_=vp0+sl_prev; \
    VRD(0); SBAR(); float sacc=(P0[0]+P0[1]); \
    GAPA(C0=__builtin_amdgcn_mfma_f32_32x32x16_bf16(kf[0],qr[0],negm,0,0,0), P0[2],P0[3],P0[4],P0[5],     pw0[0]=PKW(P0,0), pw0[1]=PKW(P0,2), pw0); \
    VRD(4); SBAR(); GAPA(C1=__builtin_amdgcn_mfma_f32_32x32x16_bf16(kf[1],qr[0],negm,0,0,0), P0[6],P0[7],P0[8],P0[9],     pw0[2]=PKW(P0,4), pw0[3]=PKW(P0,6), pw0); \
    VRD(1); SBAR(); GAPA(C0=__builtin_amdgcn_mfma_f32_32x32x16_bf16(kf[2],qr[1],C0,0,0,0),   P0[10],P0[11],P0[12],P0[13], pw1[0]=PKW(P0,8), pw1[1]=PKW(P0,10), pw1); \
    VRD(5); SBAR(); GAPA(C1=__builtin_amdgcn_mfma_f32_32x32x16_bf16(kf[3],qr[1],C1,0,0,0),   P0[14],P0[15],P1[0],P1[1],   pw1[2]=PKW(P0,12),pw1[3]=PKW(P0,14), pw1); \
    VRD(2); SBAR(); GAPA(C0=__builtin_amdgcn_mfma_f32_32x32x16_bf16(kf[4],qr[2],C0,0,0,0),   P1[2],P1[3],P1[4],P1[5],     pw2[0]=PKW(P1,0), pw2[1]=PKW(P1,2), pw2); \
    VRD(6); SBAR(); GAPA(C1=__builtin_amdgcn_mfma_f32_32x32x16_bf16(kf[5],qr[2],C1,0,0,0),   P1[6],P1[7],P1[8],P1[9],     pw2[2]=PKW(P1,4), pw2[3]=PKW(P1,6), pw2); \
    VRD(3); SBAR(); GAPA(C0=__builtin_amdgcn_mfma_f32_32x32x16_bf16(kf[6],qr[3],C0,0,0,0),   P1[10],P1[11],P1[12],P1[13], pw3[0]=PKW(P1,8), pw3[1]=PKW(P1,10), pw3); \
    VRD(7); SBAR(); GAPA(C1=__builtin_amdgcn_mfma_f32_32x32x16_bf16(kf[7],qr[3],C1,0,0,0),   P1[14],P1[15],0.f,0.f,       pw3[2]=PKW(P1,12),pw3[3]=PKW(P1,14), pw3); \
    l_reg+=sacc; \
    if(GK){DMA_K((t)+3,sl_cur);} if(GV){DMA_V((t)+1,sl_next);} \
    BIAS1(C1); CMASK(C0,C1,t); \
    { float a=MX3(C0[0],C0[1],C1[0]),b=MX3(C0[2],C0[3],C1[1]); a=MX3(a,C1[2],C1[3]); \
      _Pragma("unroll") for(int r=4;r<16;r+=4){a=MX3(a,C0[r],C0[r+1]);b=MX3(b,C0[r+2],C0[r+3]);a=MX3(a,C1[r],C1[r+1]);b=MX3(b,C1[r+2],C1[r+3]);} \
      float rm=__builtin_fmaxf(a,b); { auto rr=__builtin_amdgcn_permlane32_swap(__float_as_uint(rm),__float_as_uint(rm),false,false); rm=__builtin_fmaxf(__uint_as_float(rr[0]),__uint_as_float(rr[1])); } \
      resc=false; \
      if(__builtin_expect(__any(rm>(float)THRL),0)){ const float dl=__builtin_fmaxf(rm,0.f); mhat+=dl; \
        _Pragma("unroll") for(int r=0;r<16;++r){C0[r]-=dl;C1[r]-=dl;} \
        const float f=__builtin_amdgcn_exp2f(-dl); l_reg*=f; if(hi==0)wsf[r32]=f; resc=true; } } \
    SBAR(); \
    GAPB(o[0]=__builtin_amdgcn_mfma_f32_32x32x16_bf16(PAF(0),VFR(0),o[0],0,0,0), C0,0); \
    GAPB(o[1]=__builtin_amdgcn_mfma_f32_32x32x16_bf16(PAF(0),VFR(4),o[1],0,0,0), C0,4); \
    KRD(GL,0); GAPB(o[0]=__builtin_amdgcn_mfma_f32_32x32x16_bf16(PAF(1),VFR(1),o[0],0,0,0), C0,8); \
    KRD(GL,1); GAPB(o[1]=__builtin_amdgcn_mfma_f32_32x32x16_bf16(PAF(1),VFR(5),o[1],0,0,0), C0,12); \
    KRD(GL,2); GAPB(o[0]=__builtin_amdgcn_mfma_f32_32x32x16_bf16(PAF(2),VFR(2),o[0],0,0,0), C1,0); \
    KRD(GL,3); GAPB(o[1]=__builtin_amdgcn_mfma_f32_32x32x16_bf16(PAF(2),VFR(6),o[1],0,0,0), C1,4); \
    GAPB(o[0]=__builtin_amdgcn_mfma_f32_32x32x16_bf16(PAF(3),VFR(3),o[0],0,0,0), C1,8); \
    GAPB(o[1]=__builtin_amdgcn_mfma_f32_32x32x16_bf16(PAF(3),VFR(7),o[1],0,0,0), C1,12); \
    }while(0)
  int t=1;
  #undef CMASK
  #define CMASK(P0,P1,t) do{}while(0)
  for(;t+5<NT;t+=2){
    STEP(pB0,pB1,pA0,pA1,t,true,true,true);     WAIT_BAR(2); RESC(); ROT();
    STEP(pA0,pA1,pB0,pB1,t+1,true,true,true);   WAIT_BAR(2); RESC(); ROT();
  }
  #undef CMASK
  #define CMASK(P0,P1,t) do{int jb_=(t)-(NT-4); if(jb_>=0)cmask(P0,P1,jb_,qrel,hi);}while(0)
  #define ENDW(tt) do{ if((tt)+3<NT){WAIT_BAR(2);} else if((tt)+2<NT){WAIT_BAR(1);} else {WAIT_BAR(0);} }while(0)
  for(;t+1<NT;t+=2){
    STEP(pB0,pB1,pA0,pA1,t,(t+3<NT),(t+1<NT),(t+1<NT));       ENDW(t);   RESC(); ROT();
    STEP(pA0,pA1,pB0,pB1,t+1,(t+4<NT),(t+2<NT),(t+2<NT));     ENDW(t+1); RESC(); ROT();
  }
  STEP(pB0,pB1,pA0,pA1,NT-1,false,false,false); RESC();
  { float sacc=pB0[0]+pB0[1]; _Pragma("unroll") for(int r=2;r<16;++r)sacc+=pB0[r]; _Pragma("unroll") for(int r=0;r<16;++r)sacc+=pB1[r]; l_reg+=sacc;
    pw0=(u32x4){PKW(pB0,0),PKW(pB0,2),PKW(pB0,4),PKW(pB0,6)};pw1=(u32x4){PKW(pB0,8),PKW(pB0,10),PKW(pB0,12),PKW(pB0,14)};pw2=(u32x4){PKW(pB1,0),PKW(pB1,2),PKW(pB1,4),PKW(pB1,6)};pw3=(u32x4){PKW(pB1,8),PKW(pB1,10),PKW(pB1,12),PKW(pB1,14)};
    SBAR(); pv(o,vb0+sl_cur,PAF(0),PAF(1),PAF(2),PAF(3)); }
  #undef PKW
  #undef PAF
  #undef VFR
  #undef PIN
  #undef MX3
  #undef GAPA
  #undef GAPB
  #undef EX
  #undef VRD
  #undef KRD
  #undef STEP
  #undef ENDW
  {auto rr=__builtin_amdgcn_permlane32_swap(__float_as_uint(l_reg),__float_as_uint(l_reg),false,false);l_reg=__uint_as_float(rr[0])+__uint_as_float(rr[1]);}
  if(hi==0)wsf[32+r32]=l_reg;asm volatile("s_waitcnt lgkmcnt(0)":::"memory");
  float rli[16];
  #pragma unroll
  for(int r=0;r<16;++r)rli[r]=__builtin_amdgcn_rcpf(wsf[32+crow(r,hi)]);
  bf16*Ow=O+(rowbase+q0+wid*QBLK)*DMO+512+h*D; const bf16*Zw=Z+(rowbase+q0+wid*QBLK)*DM+h*D;
  { bf16*stg=(bf16*)(shm+LDS_OST)+wid*2048;
    #pragma unroll
    for(int r=0;r<16;++r){const int orow=crow(r,hi);
      #pragma unroll
      for(int d0=0;d0<2;++d0)stg[orow*64+d0*32+r32]=__float2bfloat16(o[d0][r]*rli[r]);}
    asm volatile("s_waitcnt lgkmcnt(0)":::"memory");
    #pragma unroll
    for(int i=0;i<4;++i){const int row=i*8+(lane>>3),ch=lane&7; const u32x4 v=*(const u32x4*)(stg+row*64+ch*8); const u32x4 z=*(const u32x4*)(Zw+(long)row*DM+ch*8); u32x4 w;
      #pragma unroll
      for(int e=0;e<4;++e){ const float zl=__uint_as_float(z[e]<<16),zh=__uint_as_float(z[e]&0xffff0000u),ol=__uint_as_float(v[e]<<16),oh=__uint_as_float(v[e]&0xffff0000u);
        w[e]=cvtpk_s(ol*zl/(1.f+__expf(-zl)),oh*zh/(1.f+__expf(-zh))); }
      ATTN_STORE16(Ow+(long)row*DMO+ch*8,w);} }
  asm volatile("s_waitcnt lgkmcnt(0)\n\ts_barrier":::"memory");
  #undef DMA_K
  #undef DMA_V
  #undef CMASK
  #undef START
  #undef RESC
  #undef ROT
  #undef NEGM_SET
  #undef BIAS1
}
constexpr int ATTN_LDS_BYTES=LDS_BYTES;
struct AttnTensors { const bf16* Q; const bf16* K; const bf16* V; const bf16* Z; bf16* O; const float* kmean; };
struct AttnUnit { int bh; int qb; };
struct StaticOrder {
  int vcu, G;
  __device__ __forceinline__ StaticOrder(int grid,int v):vcu(v),G(grid){}
  __device__ __forceinline__ bool next(int i,AttnUnit&u)const{ const int v=vcu+(i>>1)*G; if(v>=256)return false; const int s=v&3; u.bh=v>>2; u.qb=(i&1)?s:7-s; return true; }
};
template<class Sched,int THRL=8> __device__ __forceinline__ void attn_phase(char*lds,const AttnTensors&T,const Sched&S){
  AttnUnit u;
  for(int i=0;S.next(i,u);++i){ attn_unit<THRL>(u.bh/NHEAD,u.bh%NHEAD,u.qb,T.Q,T.K,T.V,T.Z,T.O,T.kmean+(size_t)u.bh*8*64,lds); }
}
#undef SBAR
#undef WAIT_BAR
}


constexpr int NWAVES = 8;
constexpr size_t MiB = 1u << 20;
constexpr size_t WS_CTL = 0, CTL_ZERO_BYTES = 1 * MiB;
constexpr size_t WS_WTIN = 1 * MiB;
constexpr size_t WS_WTOUT = 10 * MiB;
constexpr size_t WS_ADAP = 12 * MiB;
constexpr size_t WS_ADA = 14 * MiB;
constexpr size_t WS_KMEAN = 14 * MiB + 128 * 1024;
constexpr size_t WS_GATES = 14 * MiB + 512 * 1024;
constexpr size_t WS_ROWSS = 15 * MiB;
constexpr size_t WS_MST = 16 * MiB;
constexpr size_t WS_H = 32 * MiB;
constexpr size_t WS_PROJ = 64 * MiB;
constexpr size_t WS_QKC = 208 * MiB;
constexpr size_t WS_SMALL = 240 * MiB;
constexpr size_t WS_END = 256 * MiB;
constexpr int CW_BAR = 4096;

constexpr int RING_BYTES = 131072;
constexpr int LDSCTL_OFF = RING_BYTES, MISC_OFF = LDSCTL_OFF + 320;
constexpr int LDS_BYTES = 147456;

#define GAS __attribute__((address_space(1)))
#define LAS __attribute__((address_space(3)))
typedef unsigned v4u __attribute__((ext_vector_type(4)));
typedef float f32x4 __attribute__((ext_vector_type(4)));
typedef short bf16x8 __attribute__((ext_vector_type(8)));
#define LDS_WAIT() asm volatile("s_waitcnt lgkmcnt(0)" ::: "memory")
#define VM_WAIT() asm volatile("s_waitcnt vmcnt(0)" ::: "memory")
__device__ __forceinline__ unsigned f2bf(float f) { unsigned u = __builtin_bit_cast(unsigned, f); return (u + 0x7fffu + ((u >> 16) & 1u)) >> 16; }
__device__ __forceinline__ unsigned pk2(float lo, float hi) { return f2bf(lo) | (f2bf(hi) << 16); }
__device__ __forceinline__ float bf2f(bf16_t h) { return __uint_as_float(((unsigned)h) << 16); }
__device__ __forceinline__ float siluf(float v) { return v / (1.0f + __expf(-v)); }
__device__ __forceinline__ float sigmoidf_(float v) { return 1.0f / (1.0f + __expf(-v)); }
__device__ __forceinline__ int orig_col(int np) { return np < 2048 ? np : np + 8; }

#define XB_TMO      128
#define XB_XCNT(j)  (256  + 64 * (j))
#define XB_XSUB(j)  (1280 + 64 * (j))
#define XB_XGEN(j)  (2304 + 64 * (j))
#define XB_TOP      3328
#define XB_TOPGEN   3392
#define XCD_BAR_WORDS 3456
#define XB_SPIN_CAP (1u << 18)
__device__ __forceinline__ unsigned xb_ld(unsigned* p)              { return __hip_atomic_load(p, __ATOMIC_RELAXED, __HIP_MEMORY_SCOPE_AGENT); }
__device__ __forceinline__ unsigned xb_add(unsigned* p, unsigned v) { return __hip_atomic_fetch_add(p, v, __ATOMIC_RELAXED, __HIP_MEMORY_SCOPE_AGENT); }
__device__ __forceinline__ unsigned xb_xcc_id() { return (unsigned)__builtin_amdgcn_s_getreg((3 << 11) | 20) & 0xFu; }
#define XB_SPIN(cond, bar) do { unsigned _sp = 0; while (cond) { __builtin_amdgcn_s_sleep(1); \
    if ((++_sp & 255u) == 0u) { if (xb_ld(&(bar)[XB_TMO])) break; if (_sp > XB_SPIN_CAP) { atomicAdd(&(bar)[XB_TMO], 1u); break; } } } } while (0)
struct XcdBarrier { unsigned* bar; unsigned x; volatile LAS unsigned* st; };
__device__ __forceinline__ XcdBarrier xcd_barrier_post(unsigned* bar, volatile LAS unsigned* st) {
    XcdBarrier b; b.bar = bar; b.x = xb_xcc_id(); b.st = st;
    if (threadIdx.x == 0) (void)xb_add(&bar[XB_XCNT(b.x)], 1u);
    return b;
}
__device__ __forceinline__ void xcd_barrier_complete(unsigned* bar, unsigned x, unsigned& nloc, unsigned& nx) {
    const unsigned G = gridDim.x * gridDim.y * gridDim.z;
    unsigned sum, cnt, mine, sp = 0u;
    for (;;) {
        sum = 0u; cnt = 0u; mine = 0u;
#pragma unroll
        for (unsigned j = 0; j < 16; ++j) { const unsigned c = xb_ld(&bar[XB_XCNT(j)]); sum += c; cnt += (c > 0u) ? 1u : 0u; mine = (j == x) ? c : mine; }
        if (sum == G) break;
        __builtin_amdgcn_s_sleep(1);
        if ((++sp & 255u) == 0u) { if (xb_ld(&bar[XB_TMO])) break; if (sp > XB_SPIN_CAP) { atomicAdd(&bar[XB_TMO], 1u); break; } }
    }
    nloc = mine > 0u ? mine : 1u; nx = cnt > 0u ? cnt : 1u;
}
__device__ __forceinline__ void xcd_barrier(const XcdBarrier& b) {
    asm volatile("s_waitcnt vmcnt(0)" ::: "memory");
    __syncthreads();
    if (threadIdx.x == 0) {
        unsigned* bar = b.bar;
        __builtin_amdgcn_s_waitcnt(0);
        unsigned nloc = b.st[0], nx = b.st[1];
        if (nloc == 0u) { xcd_barrier_complete(bar, b.x, nloc, nx); b.st[0] = nloc; b.st[1] = nx; }
        const unsigned old = xb_add(&bar[XB_XSUB(b.x)], 1u);
        const unsigned gen = old / nloc;
        if (old + 1u == (gen + 1u) * nloc) {
            __builtin_amdgcn_fence(__ATOMIC_RELEASE, "agent");
            asm volatile("s_waitcnt vmcnt(0)" ::: "memory");
            const unsigned og = xb_add(&bar[XB_TOP], 1u);
            const unsigned tg = og / nx;
            if (og + 1u == (tg + 1u) * nx) xb_add(&bar[XB_TOPGEN], 1u);
            else XB_SPIN(xb_ld(&bar[XB_TOPGEN]) == tg, bar);
            __builtin_amdgcn_fence(__ATOMIC_ACQUIRE, "agent");
            xb_add(&bar[XB_XGEN(b.x)], 1u);
            asm volatile("s_waitcnt vmcnt(0)" ::: "memory");
        } else {
            XB_SPIN(xb_ld(&bar[XB_XGEN(b.x)]) == gen, bar);
            __builtin_amdgcn_fence(__ATOMIC_ACQUIRE, "agent");
            asm volatile("s_waitcnt vmcnt(0)" ::: "memory");
        }
    }
    __syncthreads();
}

struct Frame {
    LAS unsigned char* lds;
    volatile LAS unsigned* MISC;
    int tid, lane, wave, vcu, G;
    const float *x, *c, *w_ada, *b_ada, *g_norm, *w_in, *conv_w, *conv_b, *b_ig, *b_fg, *g_head, *w_out, *g_final;
    float* out;
    unsigned char* ws;
};
__device__ __forceinline__ float wave_sum(float v) {
#pragma unroll
    for (int o = 1; o < 64; o <<= 1) v += __shfl_xor(v, o);
    return v;
}

__device__ __forceinline__ void p0_transpose_item(const float* W, int ldw, bool remap, bf16_t* WT, LAS float* scr, int kb, int nb, int lane) {
    const int k0 = 64 * kb, n0 = 32 * nb; const int c0 = remap ? orig_col(n0) : n0;
#pragma unroll 8
    for (int i = 0; i < 32; ++i) { const int kk = 2 * i + (lane >> 5); scr[kk * 33 + (lane & 31)] = W[(size_t)(k0 + kk) * ldw + c0 + (lane & 31)]; }
    LDS_WAIT(); asm volatile("" ::: "memory");
    const int c = lane & 7;
#pragma unroll
    for (int j = 0; j < 4; ++j) { const int n = (lane >> 3) + 8 * j; const LAS float* s = scr + (8 * c) * 33 + n;
        v4u o; o.x = pk2(s[0 * 33], s[1 * 33]); o.y = pk2(s[2 * 33], s[3 * 33]); o.z = pk2(s[4 * 33], s[5 * 33]); o.w = pk2(s[6 * 33], s[7 * 33]);
        *(GAS v4u*)(WT + (size_t)(n0 + n) * 1024 + k0 + 8 * c) = o; }
    LDS_WAIT(); asm volatile("" ::: "memory");
}
__device__ __forceinline__ void p0_prologue(Frame& F) {
    LAS float* scr = (LAS float*)(F.lds + F.wave * 8448);
    LAS float* sc = (LAS float*)(F.lds + 69632);
    for (int e = F.tid; e < 8192; e += NWAVES * 64) { const int b = e >> 10, k = e & 1023; sc[k * 8 + b] = siluf(F.c[e]); }
    __syncthreads();
    const int gw = F.vcu * NWAVES + F.wave, NGW = F.G * NWAVES;
    constexpr int I_ADA = 48 * NKS, I_IN = 16 * (NP / 32), I_OUT = 16 * 32;
    float* adaP = (float*)(F.ws + WS_ADAP);
    bf16_t* WtIn = (bf16_t*)(F.ws + WS_WTIN); bf16_t* WtOut = (bf16_t*)(F.ws + WS_WTOUT);
    for (int it = gw; it < I_ADA + I_IN + I_OUT; it += NGW) {
        int r = it;
        if (r < I_ADA) {
            const int cg = r % 48, ks = r / 48, j = cg * 64 + F.lane;
            float acc[8];
#pragma unroll
            for (int b = 0; b < 8; ++b) acc[b] = 0.f;
            const float* wp = F.w_ada + (size_t)(ks * 64) * 3072 + j;
#pragma unroll 4
            for (int k = 0; k < 64; ++k) { const float w = wp[(size_t)k * 3072];
                const f32x4 s0 = *(const LAS f32x4*)(sc + (ks * 64 + k) * 8), s1 = *(const LAS f32x4*)(sc + (ks * 64 + k) * 8 + 4);
                acc[0] += s0[0] * w; acc[1] += s0[1] * w; acc[2] += s0[2] * w; acc[3] += s0[3] * w;
                acc[4] += s1[0] * w; acc[5] += s1[1] * w; acc[6] += s1[2] * w; acc[7] += s1[3] * w; }
#pragma unroll
            for (int b = 0; b < 8; ++b) adaP[((size_t)ks * 8 + b) * 3072 + j] = acc[b];
            continue;
        }
        r -= I_ADA;
        if (r < I_IN) { p0_transpose_item(F.w_in, NPROJ, true, WtIn, scr, r / (NP / 32), r % (NP / 32), F.lane); continue; }
        r -= I_IN;
        p0_transpose_item(F.w_out, 1024, false, WtOut, scr, r / 32, r % 32, F.lane);
    }
}

__device__ __forceinline__ void p1_norm(Frame& F) {
    LAS float* gs = (LAS float*)(F.lds); LAS float* sh = gs + 1024;
    const float* adaP = (const float*)(F.ws + WS_ADAP);
    float* ada = (float*)(F.ws + WS_ADA);
    if (true) { for (int e = blockIdx.x * (NWAVES * 64) + F.tid; e < 8 * 3072; e += F.G * NWAVES * 64) { float v = F.b_ada[e % 3072];
#pragma unroll
        for (int s = 0; s < NKS; ++s) v += adaP[(size_t)s * 8 * 3072 + e];
        ada[e] = v; } }
    bf16_t* H = (bf16_t*)(F.ws + WS_H); float* gates = (float*)(F.ws + WS_GATES);
    f32x4 wg[4][4][2];
#pragma unroll
    for (int j = 0; j < 4; ++j)
#pragma unroll
        for (int i = 0; i < 4; ++i) { const float* wp = F.w_in + (size_t)(4 * F.lane + 256 * j + i) * NPROJ + 2048; wg[j][i][0] = *(const f32x4*)wp; wg[j][i][1] = *(const f32x4*)(wp + 4); }
    for (int rb = F.vcu; rb < T_ / 64; rb += F.G) {
        const int r0 = 64 * rb, b = r0 / S_;
        for (int k = F.tid; k < 1024; k += NWAVES * 64) {
            float scl = F.b_ada[1024 + k], sft = F.b_ada[k];
#pragma unroll
            for (int s = 0; s < NKS; ++s) { scl += adaP[((size_t)s * 8 + b) * 3072 + 1024 + k]; sft += adaP[((size_t)s * 8 + b) * 3072 + k]; }
            gs[k] = F.g_norm[k] * (1.0f + scl); sh[k] = sft;
        }
        __syncthreads();
        f32x4 gsv[4], shv[4];
#pragma unroll
        for (int j = 0; j < 4; ++j) { gsv[j] = *(const LAS f32x4*)(gs + 4 * F.lane + 256 * j); shv[j] = *(const LAS f32x4*)(sh + 4 * F.lane + 256 * j); }
        for (int rr = 0; rr < 8; ++rr) {
            const int m = r0 + F.wave * 8 + rr;
            const GAS f32x4* xr = (const GAS f32x4*)(F.x + (size_t)m * D_) + F.lane;
            f32x4 v[4]; float s = 0.f;
#pragma unroll
            for (int j = 0; j < 4; ++j) { v[j] = xr[64 * j]; s += (v[j].x * v[j].x + v[j].y * v[j].y) + (v[j].z * v[j].z + v[j].w * v[j].w); }
            const float rstd = rsqrtf(wave_sum(s) * (1.f / D_) + 1e-6f);
            float ga[8];
#pragma unroll
            for (int c = 0; c < 8; ++c) ga[c] = 0.f;
            GAS unsigned long long* o8 = (GAS unsigned long long*)(H + (size_t)m * D_) + F.lane;
#pragma unroll
            for (int j = 0; j < 4; ++j) {
                f32x4 hv = v[j] * rstd * gsv[j] + shv[j];
                o8[64 * j] = (unsigned long long)pk2(hv.x, hv.y) | ((unsigned long long)pk2(hv.z, hv.w) << 32);
#pragma unroll
                for (int i = 0; i < 4; ++i)
#pragma unroll
                    for (int c = 0; c < 8; ++c) ga[c] += hv[i] * wg[j][i][c >> 2][c & 3];
            }
#pragma unroll
            for (int c = 0; c < 8; ++c) ga[c] = wave_sum(ga[c]);
            if (F.lane == 0) { *(f32x4*)(gates + (size_t)m * 8) = (f32x4){ga[0], ga[1], ga[2], ga[3]}; *(f32x4*)(gates + (size_t)m * 8 + 4) = (f32x4){ga[4], ga[5], ga[6], ga[7]}; }
        }
        __syncthreads();
    }
}

constexpr float QSCALE = 0.125f * 1.4426950408889634f;

__device__ __forceinline__ void p6_final(Frame& F) {
    const int gw = F.vcu * NWAVES + F.wave, NGW = F.G * NWAVES;
    const float* rowss = (const float*)(F.ws + WS_ROWSS);
    f32x4 gf[4];
#pragma unroll
    for (int j = 0; j < 4; ++j) gf[j] = *(const f32x4*)(F.g_final + 4 * F.lane + 256 * j);
    for (int m = gw; m < T_; m += NGW) {
        const f32x4* pr = (const f32x4*)(rowss + (size_t)m * 16);
        const f32x4 p0 = pr[0], p1 = pr[1], p2 = pr[2], p3 = pr[3];
        const float ss = ((p0[0] + p0[1]) + (p0[2] + p0[3])) + ((p1[0] + p1[1]) + (p1[2] + p1[3])) + ((p2[0] + p2[1]) + (p2[2] + p2[3])) + ((p3[0] + p3[1]) + (p3[2] + p3[3]));
        const float rstd = rsqrtf(ss * (1.f / D_) + 1e-6f);
        GAS f32x4* xr = (GAS f32x4*)(F.out + (size_t)m * D_) + F.lane;
#pragma unroll
        for (int j = 0; j < 4; ++j) { f32x4 v = xr[64 * j]; xr[64 * j] = v * rstd * gf[j]; }
    }
}

struct Args { const float* in[13]; float* out; unsigned char* ws; int ph_lo, ph_hi, li, pad; };
__global__ void __launch_bounds__(NWAVES * 64, 2) mk_fwd(Args args) {
    extern __shared__ __attribute__((aligned(16))) unsigned char lds[];
    Frame F;
    F.lds = (LAS unsigned char*)lds;
    F.MISC = (volatile LAS unsigned*)(F.lds + MISC_OFF);
    F.tid = threadIdx.x; F.lane = F.tid & 63; F.wave = __builtin_amdgcn_readfirstlane(F.tid >> 6);
    F.G = gridDim.x; { const int bx = blockIdx.x; F.vcu = (F.G % 8 == 0) ? (bx % 8) * (F.G / 8) + bx / 8 : bx; }
    F.x = args.in[0]; F.c = args.in[1]; F.w_ada = args.in[2]; F.b_ada = args.in[3]; F.g_norm = args.in[4]; F.w_in = args.in[5];
    F.conv_w = args.in[6]; F.conv_b = args.in[7]; F.b_ig = args.in[8]; F.b_fg = args.in[9]; F.g_head = args.in[10]; F.w_out = args.in[11]; F.g_final = args.in[12];
    F.out = args.out; F.ws = args.ws;
    for (int u = F.tid; u < (LDS_BYTES - LDSCTL_OFF) / 4; u += NWAVES * 64) ((LAS unsigned*)(F.lds + LDSCTL_OFF))[u] = 0u;
    __syncthreads();
    unsigned* ctl = (unsigned*)(F.ws + WS_CTL);
    XcdBarrier bar = xcd_barrier_post(ctl + CW_BAR + args.li * XCD_BAR_WORDS, F.MISC + 8);
    const int lo = args.ph_lo, hi = args.ph_hi;
#define IN(k) (lo <= (k) && (k) < hi)
#define BOTH(k) (IN(k) && IN((k) + 1))
    if (IN(0)) { p0_prologue(F); if (BOTH(0)) xcd_barrier(bar); }
    if (IN(1)) { p1_norm(F); if (BOTH(1)) xcd_barrier(bar); }
    if (IN(2)) {
        pg8::Gemm g{(const bf16_t*)(F.ws + WS_H), (const bf16_t*)(F.ws + WS_WTIN), T_, NP, D_};
        pg8::StaticOrder S; S.init(T_, NP, F.G, (int)blockIdx.x);
        pg8::EpiProj E{(bf16_t*)(F.ws + WS_PROJ), NP, OQB / 256, OKB / 256, QSCALE};
        pg8::gemm_phase<pg8::EpiProj, pg8::StaticOrder, true, true>(F.lds, g, S, E);
        if (BOTH(2)) xcd_barrier(bar);
    }
    if (IN(4)) {
        typedef moba_body::bf16 mb16;
        const moba_body::AttnTensors AT{(const mb16*)(F.ws + WS_PROJ) + OQB, (const mb16*)(F.ws + WS_PROJ) + OKB, (const mb16*)(F.ws + WS_PROJ) + OVB, (const mb16*)(F.ws + WS_PROJ) + OZB,
                                        (mb16*)(F.ws + WS_H), (const float*)(F.ws + WS_KMEAN)};
        const moba_body::StaticOrder S((int)F.G, F.vcu);
        moba_body::attn_phase<moba_body::StaticOrder>((char*)lds, AT, S);
        if (BOTH(4)) xcd_barrier(bar);
    }
    if (IN(5)) {
        pg8::Gemm g{(const bf16_t*)(F.ws + WS_H), (const bf16_t*)(F.ws + WS_WTOUT), T_, D_, D_};
        pg8::StaticOrder S; S.init(T_, D_, F.G, (int)blockIdx.x);
        pg8::EpiOut E{F.x, (const float*)(F.ws + WS_ADA), F.out, (float*)(F.ws + WS_ROWSS)};
        pg8::gemm_phase<pg8::EpiOut, pg8::StaticOrder, true, true>(F.lds, g, S, E);
        if (BOTH(5)) xcd_barrier(bar);
    }
    if (IN(6)) { p6_final(F); }
#undef IN
#undef BOTH
}

template <int MODE>
__global__ void __launch_bounds__(256) k_gemm_naive(const bf16_t* __restrict__ A, const float* __restrict__ W,
                                                    bf16_t* __restrict__ Cb, float* __restrict__ Cf, int N, int ldw) {
  __shared__ float As[16][65];
  __shared__ float Bs[16][65];
  int tx = threadIdx.x & 15, ty = threadIdx.x >> 4;
  int m0 = blockIdx.y * 64, n0 = blockIdx.x * 64;
  float acc[4][4];
  for (int i = 0; i < 4; ++i) for (int j = 0; j < 4; ++j) acc[i][j] = 0.f;
  for (int k0 = 0; k0 < 1024; k0 += 16) {
    for (int e = threadIdx.x; e < 1024; e += 256) {
      int kk = e & 15, mm = e >> 4;
      As[kk][mm] = bf2f(A[(size_t)(m0 + mm) * 1024 + k0 + kk]);
      int nn = e & 63, k2 = e >> 6;
      int n = n0 + nn;
      float wv = 0.f;
      if (n < N) {
        int oc = (MODE == 0) ? orig_col(n) : n;
        wv = W[(size_t)(k0 + k2) * ldw + oc];
      }
      Bs[k2][nn] = wv;
    }
    __syncthreads();
    for (int kk = 0; kk < 16; ++kk) {
      float a[4], bb[4];
      for (int i = 0; i < 4; ++i) a[i] = As[kk][ty * 4 + i];
      for (int j = 0; j < 4; ++j) bb[j] = Bs[kk][tx * 4 + j];
      for (int i = 0; i < 4; ++i) for (int j = 0; j < 4; ++j) acc[i][j] += a[i] * bb[j];
    }
    __syncthreads();
  }
  for (int i = 0; i < 4; ++i) for (int j = 0; j < 4; ++j) {
    int m = m0 + ty * 4 + i, n = n0 + tx * 4 + j;
    if (n >= N) continue;
    if (MODE == 0) {
      if (n < NP) Cb[(size_t)m * NP + n] = f2bf(acc[i][j]);
      else Cf[(size_t)m * 8 + (n - NP)] = acc[i][j];
    } else {
      Cf[(size_t)m * 1024 + n] = acc[i][j];
    }
  }
}

__global__ void __launch_bounds__(256) k_conv(const bf16_t* __restrict__ proj, const float* __restrict__ conv_w,
                                              const float* __restrict__ conv_b, bf16_t* __restrict__ qkc) {
  int t = blockIdx.x;
  int s = t % S_;
  for (int ch = threadIdx.x; ch < 1024; ch += 256) {
    float acc = conv_b[ch];
    for (int tap = 0; tap < 4; ++tap) {
      int ss = s - 3 + tap;
      if (ss >= 0) acc += bf2f(proj[(size_t)(t - 3 + tap) * NP + ch]) * conv_w[tap * 1024 + ch];
    }
    float v = siluf(acc);
    if (ch >= 512) v *= 0.08838834764831845f;
    qkc[(size_t)t * 1024 + ch] = f2bf(v);
  }
}

__global__ void __launch_bounds__(256) k_cloc(const bf16_t* __restrict__ proj, const bf16_t* __restrict__ qkc,
                                              const float* __restrict__ gates, const float* __restrict__ b_i,
                                              const float* __restrict__ b_f, float* __restrict__ Cst,
                                              float* __restrict__ nst, float* __restrict__ amax, float* __restrict__ ftot) {
  __shared__ float logf_[64], cumf[64], a_[64], w_[64];
  __shared__ float ks[64][129];
  int bhc = blockIdx.x;
  int c = bhc & 31, h = (bhc >> 5) & 3, b = bhc >> 7;
  int t0 = b * S_ + c * 64;
  int tid = threadIdx.x;
  if (tid < 64) {
    float fp = gates[(size_t)(t0 + tid) * 8 + 4 + h] + b_f[h];
    float lf = (fp > 0.f) ? -log1pf(__expf(-fp)) : (fp - log1pf(__expf(fp)));
    logf_[tid] = lf;
  }
  for (int e = tid; e < 64 * 128; e += 256) {
    int s = e >> 7, k = e & 127;
    ks[s][k] = bf2f(qkc[(size_t)(t0 + s) * 1024 + 512 + h * 128 + k]);
  }
  __syncthreads();
  if (tid == 0) {
    float cs = 0.f;
    for (int s = 0; s < 64; ++s) { cs += logf_[s]; cumf[s] = cs; }
  }
  __syncthreads();
  if (tid < 64) {
    float ip = gates[(size_t)(t0 + tid) * 8 + h] + b_i[h];
    a_[tid] = cumf[63] - cumf[tid] + ip;
  }
  __syncthreads();
  if (tid == 0) {
    float m = a_[0];
    for (int s = 1; s < 64; ++s) m = fmaxf(m, a_[s]);
    amax[bhc] = m; ftot[bhc] = cumf[63];
    logf_[0] = m;
  }
  __syncthreads();
  if (tid < 64) w_[tid] = __expf(a_[tid] - logf_[0]);
  __syncthreads();
  int k = tid & 127;
  for (int v = (tid >> 7); v < 128; v += 2) {
    float acc = 0.f;
    for (int s = 0; s < 64; ++s) {
      float vv = bf2f(proj[(size_t)(t0 + s) * NP + OVM + h * 128 + v]);
      acc += w_[s] * vv * ks[s][k];
    }
    Cst[(size_t)bhc * 16384 + v * 128 + k] = acc;
  }
  if (tid < 128) {
    float acc = 0.f;
    for (int s = 0; s < 64; ++s) acc += w_[s] * ks[s][tid];
    nst[(size_t)bhc * 128 + tid] = acc;
  }
}

__global__ void __launch_bounds__(256) k_scan(float* __restrict__ Cst, float* __restrict__ nst,
                                              const float* __restrict__ amax, const float* __restrict__ ftot,
                                              float* __restrict__ mprev) {
  int bh = blockIdx.y;
  int e = blockIdx.x * 256 + threadIdx.x;
  if (e >= 16384 + 128) return;
  float st = 0.f, m = 0.f;
  for (int c = 0; c < 32; ++c) {
    int bhc = bh * 32 + c;
    float am = amax[bhc], ft = ftot[bhc];
    float mn = fmaxf(ft + m, am);
    float so = __expf(ft + m - mn), sn = __expf(am - mn);
    float* p = (e < 16384) ? (Cst + (size_t)bhc * 16384 + e) : (nst + (size_t)bhc * 128 + (e - 16384));
    float loc = *p;
    *p = st;
    if (e == 0) mprev[bhc] = m;
    st = so * st + sn * loc;
    m = mn;
  }
}

__global__ void __launch_bounds__(256) k_mout(const bf16_t* __restrict__ proj, const bf16_t* __restrict__ qkc,
                                              const float* __restrict__ gates, const float* __restrict__ b_i,
                                              const float* __restrict__ b_f, const float* __restrict__ Cst,
                                              const float* __restrict__ nst, const float* __restrict__ mprev,
                                              const float* __restrict__ g_head, bf16_t* __restrict__ mix) {
  __shared__ float logf_[64], cumf[64], logi[64], mt[64], isc[64], den[64], rn[64];
  __shared__ float Sm[64][65];
  __shared__ float hs[64][129];
  int bhc = blockIdx.x;
  int c = bhc & 31, h = (bhc >> 5) & 3, b = bhc >> 7;
  int t0 = b * S_ + c * 64;
  int tid = threadIdx.x;
  float mp = mprev[bhc];
  if (tid < 64) {
    float fp = gates[(size_t)(t0 + tid) * 8 + 4 + h] + b_f[h];
    float lf = (fp > 0.f) ? -log1pf(__expf(-fp)) : (fp - log1pf(__expf(fp)));
    logf_[tid] = lf;
    logi[tid] = gates[(size_t)(t0 + tid) * 8 + h] + b_i[h];
  }
  __syncthreads();
  if (tid == 0) {
    float cs = 0.f;
    for (int s = 0; s < 64; ++s) { cs += logf_[s]; cumf[s] = cs; }
  }
  __syncthreads();
  if (tid < 64) {
    int t = tid;
    float mi = cumf[t] + mp;
    float mx = -INFINITY;
    for (int s = 0; s <= t; ++s) mx = fmaxf(mx, cumf[t] - cumf[s] + logi[s]);
    float m = fmaxf(mi, mx);
    mt[t] = m;
    isc[t] = __expf(mi - m);
  }
  __syncthreads();
  const bf16_t* qb = qkc + (size_t)t0 * 1024 + h * 128;
  const bf16_t* kb = qkc + (size_t)t0 * 1024 + 512 + h * 128;
  for (int e = tid; e < 4096; e += 256) {
    int t = e >> 6, s = e & 63;
    float val = 0.f;
    if (s <= t) {
      float dot = 0.f;
      for (int k = 0; k < 128; ++k) dot += bf2f(qb[(size_t)t * 1024 + k]) * bf2f(kb[(size_t)s * 1024 + k]);
      val = dot * __expf(cumf[t] - cumf[s] + logi[s] - mt[t]);
    }
    Sm[t][s] = val;
  }
  __syncthreads();
  if (tid < 64) {
    int t = tid;
    float d = 0.f;
    for (int s = 0; s < 64; ++s) d += Sm[t][s];
    float nq = 0.f;
    for (int k = 0; k < 128; ++k) nq += nst[(size_t)bhc * 128 + k] * bf2f(qb[(size_t)t * 1024 + k]);
    d += isc[t] * nq;
    den[t] = fmaxf(fabsf(d), __expf(-mt[t]));
  }
  __syncthreads();
  for (int e = tid; e < 64 * 128; e += 256) {
    int t = e >> 7, v = e & 127;
    float acc = 0.f;
    for (int s = 0; s <= t; ++s) acc += Sm[t][s] * bf2f(proj[(size_t)(t0 + s) * NP + OVM + h * 128 + v]);
    float cq = 0.f;
    for (int k = 0; k < 128; ++k) cq += Cst[(size_t)bhc * 16384 + v * 128 + k] * bf2f(qb[(size_t)t * 1024 + k]);
    acc += isc[t] * cq;
    hs[t][v] = acc / den[t];
  }
  __syncthreads();
  if (tid < 64) {
    float ss = 0.f;
    for (int v = 0; v < 128; ++v) ss += hs[tid][v] * hs[tid][v];
    rn[tid] = rsqrtf(ss * (1.0f / 128.0f) + 1e-6f);
  }
  __syncthreads();
  for (int e = tid; e < 64 * 128; e += 256) {
    int t = e >> 7, v = e & 127;
    float hm = hs[t][v] * rn[t] * g_head[h * 128 + v];
    float om = bf2f(proj[(size_t)(t0 + t) * NP + OOM + h * 128 + v]);
    float zm = bf2f(proj[(size_t)(t0 + t) * NP + OZM + h * 128 + v]);
    mix[(size_t)(t0 + t) * 1024 + h * 128 + v] = f2bf(hm * sigmoidf_(om) * siluf(zm));
  }
}

__global__ void __launch_bounds__(64) k_kmean(const bf16_t* __restrict__ proj, float* __restrict__ kmean) {
  int bhn = blockIdx.x;
  int n = bhn & 7, h = (bhn >> 3) & 7, b = bhn >> 6;
  int d = threadIdx.x;
  float acc = 0.f;
  for (int s = 0; s < 256; ++s) acc += bf2f(proj[(size_t)(b * S_ + n * 256 + s) * NP + OKB + h * 64 + d]);
  kmean[(size_t)bhn * 64 + d] = acc * (1.0f / 256.0f);
}

__global__ void __launch_bounds__(64) k_moba(const bf16_t* __restrict__ proj, const float* __restrict__ kmean,
                                             bf16_t* __restrict__ mix) {
  int t = blockIdx.x * 64 + threadIdx.x;
  int h = blockIdx.y;
  int b = t / S_, s = t % S_;
  int j = s >> 8;
  float slope = exp2f(-(float)(h + 1));
  float q[64], o[64];
#pragma unroll
  for (int d = 0; d < 64; ++d) { q[d] = bf2f(proj[(size_t)t * NP + OQB + h * 64 + d]); o[d] = 0.f; }
  unsigned selmask = 0;
  if (j <= 3) {
    selmask = (1u << j) - 1u;
  } else {
    float gv[8];
#pragma unroll
    for (int n = 0; n < 8; ++n) {
      float acc = 0.f;
      if (n < j) {
#pragma unroll
        for (int d = 0; d < 64; ++d) acc += q[d] * kmean[(size_t)((b * 8 + h) * 8 + n) * 64 + d];
      } else acc = -INFINITY;
      gv[n] = acc;
    }
    for (int r = 0; r < 3; ++r) {
      float best = -INFINITY; int bi = -1;
#pragma unroll
      for (int n = 0; n < 8; ++n) {
        bool ok = !((selmask >> n) & 1u) && (n < j);
        if (ok && (gv[n] > best || bi < 0)) { best = gv[n]; bi = n; }
      }
      selmask |= (1u << bi);
    }
  }
  float m = -INFINITY, l = 0.f;
  for (int n = 0; n <= j; ++n) {
    bool sel = (n == j) || ((selmask >> n) & 1u);
    if (!sel) continue;
    int kend = (n == j) ? (s - j * 256 + 1) : 256;
    for (int kk = 0; kk < kend; ++kk) {
      int pk = n * 256 + kk;
      const bf16_t* kr = proj + (size_t)(b * S_ + pk) * NP + OKB + h * 64;
      float dot = 0.f;
#pragma unroll
      for (int d = 0; d < 64; ++d) dot += q[d] * bf2f(kr[d]);
      float sc = dot * 0.6931471805599453f - slope * (float)(s - pk);
      float mn = fmaxf(m, sc);
      float corr = __expf(m - mn);
      float p = __expf(sc - mn);
      l = l * corr + p;
      const bf16_t* vr = proj + (size_t)(b * S_ + pk) * NP + OVB + h * 64;
#pragma unroll
      for (int d = 0; d < 64; ++d) o[d] = o[d] * corr + p * bf2f(vr[d]);
      m = mn;
    }
  }
  float inv = 1.0f / l;
#pragma unroll
  for (int d = 0; d < 64; ++d) {
    float zb = bf2f(proj[(size_t)t * NP + OZB + h * 64 + d]);
    mix[(size_t)t * 1024 + 512 + h * 64 + d] = f2bf(o[d] * inv * siluf(zb));
  }
}

__global__ void __launch_bounds__(256) k_final(const float* __restrict__ x, const float* __restrict__ ada,
                                               const float* __restrict__ gf, float* __restrict__ out) {
  __shared__ float red[4];
  int t = blockIdx.x;
  int b = t / S_;
  float v[4];
  float ss = 0.f;
  for (int i = 0; i < 4; ++i) {
    int k = threadIdx.x + 256 * i;
    v[i] = x[(size_t)t * D_ + k] + ada[b * 3072 + 2048 + k] * out[(size_t)t * D_ + k];
    ss += v[i] * v[i];
  }
  for (int o = 32; o > 0; o >>= 1) ss += __shfl_xor(ss, o);
  if ((threadIdx.x & 63) == 0) red[threadIdx.x >> 6] = ss;
  __syncthreads();
  float tot = red[0] + red[1] + red[2] + red[3];
  float r = rsqrtf(tot * (1.0f / 1024.0f) + 1e-6f);
  for (int i = 0; i < 4; ++i) {
    int k = threadIdx.x + 256 * i;
    out[(size_t)t * D_ + k] = v[i] * r * gf[k];
  }
}


extern "C" void kernel_launch(void* const* d_in, const int* in_sizes, int n_in, void* d_out, int out_size,
                              void* d_ws, size_t ws_size, hipStream_t stream) {
  static int grid = 0;
  if (grid == 0) {
    int dev = 0, cus = 0, per_cu = 0;
    if (hipGetDevice(&dev) != hipSuccess || hipDeviceGetAttribute(&cus, hipDeviceAttributeMultiprocessorCount, dev) != hipSuccess) { grid = -1; return; }
    if (hipFuncSetAttribute((const void*)mk_fwd, hipFuncAttributeMaxDynamicSharedMemorySize, LDS_BYTES) != hipSuccess) { fprintf(stderr, "hipFuncSetAttribute failed\n"); grid = -1; return; }
    if (hipOccupancyMaxActiveBlocksPerMultiprocessor(&per_cu, (const void*)mk_fwd, NWAVES * 64, LDS_BYTES) != hipSuccess || per_cu < 1) { fprintf(stderr, "occupancy query: %d\n", per_cu); per_cu = 1; }
    (void)hipGetLastError();
    grid = cus;
    if (ws_size < WS_END) { fprintf(stderr, "workspace too small: %zu\n", ws_size); grid = -1; return; }
  }
  if (grid < 0) return;
  (void)hipMemsetAsync((char*)d_ws + WS_CTL, 0, CTL_ZERO_BYTES, stream);
  Args a{};
  for (int i = 0; i < 13; ++i) a.in[i] = (const float*)d_in[i];
  a.out = (float*)d_out; a.ws = (unsigned char*)d_ws; a.ph_lo = 0; a.ph_hi = 3; a.li = 0;
  hipLaunchKernelGGL(mk_fwd, dim3(grid), dim3(NWAVES * 64), LDS_BYTES, stream, a);

  const float* x = (const float*)d_in[0];
  const float* conv_w = (const float*)d_in[6];
  const float* conv_b = (const float*)d_in[7];
  const float* b_ig = (const float*)d_in[8];
  const float* b_fg = (const float*)d_in[9];
  const float* g_head = (const float*)d_in[10];
  const float* w_out = (const float*)d_in[11];
  const float* g_final = (const float*)d_in[12];
  float* out = (float*)d_out;
  char* ws = (char*)d_ws;
  bf16_t* proj = (bf16_t*)(ws + WS_PROJ);
  bf16_t* mix = (bf16_t*)(ws + WS_H);
  bf16_t* qkc = (bf16_t*)(ws + WS_QKC);
  float* gates = (float*)(ws + WS_GATES);
  float* ada = (float*)(ws + WS_ADA);
  float* kmean = (float*)(ws + WS_KMEAN);
  float* nst = (float*)(ws + WS_SMALL);
  float* amax = nst + 1024 * 128;
  float* ftot = amax + 1024;
  float* mprev = ftot + 1024;
  float* Cst = (float*)d_out;
  k_conv<<<T_, 256, 0, stream>>>(proj, conv_w, conv_b, qkc);
  k_cloc<<<1024, 256, 0, stream>>>(proj, qkc, gates, b_ig, b_fg, Cst, nst, amax, ftot);
  k_scan<<<dim3((16384 + 128 + 255) / 256, 32), 256, 0, stream>>>(Cst, nst, amax, ftot, mprev);
  k_mout<<<1024, 256, 0, stream>>>(proj, qkc, gates, b_ig, b_fg, Cst, nst, mprev, g_head, mix);
  k_kmean<<<512, 64, 0, stream>>>(proj, kmean);
  a.ph_lo = 4; a.ph_hi = 7; a.li = 1;
  hipLaunchKernelGGL(mk_fwd, dim3(grid), dim3(NWAVES * 64), LDS_BYTES, stream, a);
}
```

```cpp
#include <hip/hip_runtime.h>
#include <cstdio>
#include <cstdint>

#define B_ 8
#define S_ 2048
#define D_ 1024
#define T_ (B_ * S_)
#define NP 4608
#define NPROJ 4616
#define OQM 0
#define OKM 512
#define OVM 1024
#define OOM 1536
#define OZM 2048
#define OQB 2560
#define OKB 3072
#define OVB 3584
#define OZB 4096
#define NKS 16

typedef unsigned short bf16_t;
namespace pg8 {
#define PG8_LAS __attribute__((address_space(3)))
typedef unsigned short bf16_t;
typedef short bf16x8 __attribute__((ext_vector_type(8)));
typedef float f32x4 __attribute__((ext_vector_type(4)));
typedef unsigned u32x4 __attribute__((ext_vector_type(4)));
constexpr int BM = 256, BK = 64, HALF = 128, HTB = HALF * BK * 2  , STAGE_BYTES = 8 * HTB, NXCD = 8, WGM = 8;

__host__ __device__ __forceinline__ int lds_byte(int r, int c) { const int st = (r >> 4) * 2 + (c >> 5), rr = r & 15, cc = c & 31, ob = rr * 64 + cc * 2; return st * 1024 + (ob ^ (((ob >> 9) & 1) << 5)); }
__host__ __device__ __forceinline__ void stage_rc(int b, int& R, int& C) { const int st = b / 1024, sb = b % 1024, swz = sb ^ (((sb >> 9) & 1) << 5); R = (st >> 1) * 16 + swz / 64; C = (st & 1) * 32 + (swz % 64) / 2; }
__host__ __device__ __forceinline__ int perm32(int rho) { const int n = rho >> 4, i = rho & 15; return 8 * (i >> 2) + 4 * n + (i & 3); }

struct Unit { int pm, pn; };
struct Gemm { const bf16_t* A; const bf16_t* Bt; int M, N, K; };

struct StaticOrder {
    int nM, nN, nwg, G, c;
    __host__ __device__ void init(int M, int N, int G_, int c_) { nM = M / BM; nN = N / BM; nwg = nM * nN; G = G_; c = c_; }
    __host__ __device__ bool next(int i, Unit& u) const {
        const long L = (long)i * G + c; if (L >= nwg) return false;
        int wgid = (int)L; { const int q = nwg / NXCD, r = nwg % NXCD, xcd = wgid % NXCD, off = wgid / NXCD; wgid = (xcd < r ? xcd * (q + 1) : r * (q + 1) + (xcd - r) * q) + off; }
        const int nig = WGM * nN, gid = wgid / nig, fm = gid * WGM, gsz = (nM - fm) < WGM ? (nM - fm) : WGM;
        u.pm = fm + ((wgid % nig) % gsz); u.pn = (wgid % nig) / gsz; return true;
    }
    __device__ __forceinline__ void a_ready(const Unit&) const {}
    __device__ __forceinline__ void done(const Unit&) const {}
};

__device__ __forceinline__ unsigned cvt_pk_bf16(float lo, float hi) { unsigned r; asm volatile("v_cvt_pk_bf16_f32 %0, %1, %2" : "=v"(r) : "v"(lo), "v"(hi)); return r; }

struct EpiProj {
    static constexpr bool PERM = true, AFTER_DRAIN = false;
    bf16_t* O; int ldc; int qt_lo, qt_hi; float qscale;
    __device__ __forceinline__ void operator()(const f32x4 (&acc)[2][2][4][2], const Unit& u, int wr, int wc, int fr, int fq) const {
        const int row0 = u.pm * BM + wr * 64 + fr; const int col0 = u.pn * BM + wc * 32 + 8 * fq;
        const float sc = (u.pn >= qt_lo && u.pn < qt_hi) ? qscale : 1.f;
#pragma unroll
        for (int ai = 0; ai < 2; ++ai)
#pragma unroll
            for (int m = 0; m < 4; ++m) { bf16_t* rowp = O + (size_t)(row0 + ai * HALF + m * 16) * ldc + col0;
#pragma unroll
                for (int bj = 0; bj < 2; ++bj) { f32x4 v0 = acc[ai][bj][m][0] * sc, v1 = acc[ai][bj][m][1] * sc;
                    u32x4 w; w.x = cvt_pk_bf16(v0[0], v0[1]); w.y = cvt_pk_bf16(v0[2], v0[3]); w.z = cvt_pk_bf16(v1[0], v1[1]); w.w = cvt_pk_bf16(v1[2], v1[3]);
                    *(u32x4*)(rowp + bj * HALF) = w; } }
    }
};
struct EpiOut {
    static constexpr bool PERM = false, AFTER_DRAIN = false;
    const float* X; const float* gate; float* XN; float* rowss;
    __device__ __forceinline__ void operator()(const f32x4 (&acc)[2][2][4][2], const Unit& u, int wr, int wc, int fr, int fq) const {
        const int row0 = u.pm * BM + wr * 64 + fr, col0 = u.pn * BM + wc * 32 + 4 * fq;
        const float* gb = gate + (size_t)((u.pm * BM) / 2048) * 3072 + 2048;
        f32x4 gv[2][2];
#pragma unroll
        for (int bj = 0; bj < 2; ++bj)
#pragma unroll
            for (int n = 0; n < 2; ++n) gv[bj][n] = *(const f32x4*)(gb + col0 + bj * HALF + n * 16);
#pragma unroll
        for (int ai = 0; ai < 2; ++ai)
#pragma unroll
            for (int m = 0; m < 4; ++m) { const size_t ro = (size_t)(row0 + ai * HALF + m * 16) * 1024 + col0; float ss = 0.f;
#pragma unroll
                for (int bj = 0; bj < 2; ++bj)
#pragma unroll
                    for (int n = 0; n < 2; ++n) { const f32x4 xv = *(const f32x4*)(X + ro + bj * HALF + n * 16); const f32x4 r = xv + gv[bj][n] * acc[ai][bj][m][n];
                        ss += r[0] * r[0] + r[1] * r[1] + r[2] * r[2] + r[3] * r[3]; *(f32x4*)(XN + ro + bj * HALF + n * 16) = r; }
                ss += __shfl_xor(ss, 16); ss += __shfl_xor(ss, 32);
                if (fq == 0) rowss[((size_t)(row0 + ai * HALF + m * 16) * 4 + u.pn) * 4 + wc] = ss; }
    }
};
template <class Epi, class Sched, bool ALIGN_EPI = false, bool SP2 = false>
__device__ __forceinline__ void gemm_phase(PG8_LAS unsigned char* lds, const Gemm g, const Sched& S, const Epi& E) {
    const int tid = threadIdx.x, wid = __builtin_amdgcn_readfirstlane(tid >> 6), lane = tid & 63, wr = wid >> 2, wc = wid & 3, fr = lane & 15, fq = lane >> 4;
    const int K = g.K, nt = K / BK;
    unsigned voffA[2], voffB[2];
#pragma unroll
    for (int i = 0; i < 2; ++i) { int R, C; stage_rc(tid * 16 + i * 8192, R, C); const int Rb = Epi::PERM ? ((R & ~31) + perm32(R & 31)) : R;
        voffA[i] = (unsigned)(R * K + C) * 2u; voffB[i] = (unsigned)(Rb * K + C) * 2u; }
    const size_t kstep = (size_t)(BK * 2);
    const size_t hstep = (size_t)HALF * K * 2;
    const size_t tstep = 2 * hstep;
    const unsigned ldsw = (unsigned)wid * 1024u;
    const int aoff = lds_byte(wr * 64 + fr, fq * 8), boff = lds_byte(wc * 32 + fr, fq * 8);
#define PG8_SA(b, h) (((b) * 2 + (h)) * HTB)
#define PG8_SB(b, h) ((4 + (b) * 2 + (h)) * HTB)
#define PG8_STAGE(bufoff, gbase, voff) do { _Pragma("unroll") for (int _i = 0; _i < 2; ++_i) \
        __builtin_amdgcn_global_load_lds((const unsigned*)((const char*)(gbase) + (voff)[_i]), (PG8_LAS unsigned*)(lds + (bufoff) + ldsw + _i * 8192), 16, 0, 0); } while (0)
#define PG8_LDA(dst, b, h) do { _Pragma("unroll") for (int m = 0; m < 4; ++m) _Pragma("unroll") for (int k = 0; k < 2; ++k) dst[m][k] = *(const PG8_LAS bf16x8*)(lds + PG8_SA(b, h) + aoff + m * 2048 + k * 1024); } while (0)
#define PG8_LDB(dst, b, h) do { _Pragma("unroll") for (int n = 0; n < 2; ++n) _Pragma("unroll") for (int k = 0; k < 2; ++k) dst[n][k] = *(const PG8_LAS bf16x8*)(lds + PG8_SB(b, h) + boff + n * 2048 + k * 1024); } while (0)
#define PG8_MMA(ai, bj, At, Bt) do { __builtin_amdgcn_s_setprio(1); _Pragma("unroll") for (int m = 0; m < 4; ++m) _Pragma("unroll") for (int n = 0; n < 2; ++n) _Pragma("unroll") for (int k = 0; k < 2; ++k) \
        acc[ai][bj][m][n] = __builtin_amdgcn_mfma_f32_16x16x32_bf16(Bt[n][k], At[m][k], acc[ai][bj][m][n], 0, 0, 0); __builtin_amdgcn_s_setprio(0); } while (0)
#define PG8_WAIT_V(n) asm volatile("s_waitcnt vmcnt(" #n ")" ::: "memory")
#define PG8_WAIT_L(n) asm volatile("s_waitcnt lgkmcnt(" #n ")" ::: "memory")
#define PG8_BAR __builtin_amdgcn_s_barrier()
#define PG8_SCHED __builtin_amdgcn_sched_barrier(0)
    Unit cur, nxt; int ui = 0;
    if (!S.next(0, cur)) return;
    f32x4 acc[2][2][4][2];
#pragma unroll
    for (int a = 0; a < 2; ++a)
#pragma unroll
        for (int b = 0; b < 2; ++b)
#pragma unroll
            for (int m = 0; m < 4; ++m)
#pragma unroll
                for (int n = 0; n < 2; ++n) acc[a][b][m][n] = (f32x4){0.f, 0.f, 0.f, 0.f};
    bf16x8 At[4][2], B0[2][2], B1[2][2];
    const char* cA = (const char*)g.A + (size_t)cur.pm * tstep; const char* cB = (const char*)g.Bt + (size_t)cur.pn * tstep;
    S.a_ready(cur);
    if constexpr (SP2) {
        PG8_STAGE(PG8_SB(0, 0), cB, voffB); PG8_STAGE(PG8_SB(0, 1), cB + hstep, voffB); PG8_STAGE(PG8_SA(0, 0), cA, voffA); PG8_STAGE(PG8_SA(0, 1), cA + hstep, voffA);
        if (wr == 1) PG8_BAR;
        PG8_WAIT_V(2); PG8_BAR;
        PG8_STAGE(PG8_SB(1, 0), cB + kstep, voffB); PG8_STAGE(PG8_SA(1, 0), cA + kstep, voffA); PG8_STAGE(PG8_SB(1, 1), cB + hstep + kstep, voffB);
        PG8_WAIT_V(6); PG8_BAR;
    } else {
        PG8_STAGE(PG8_SB(0, 0), cB, voffB); PG8_STAGE(PG8_SA(0, 0), cA, voffA); PG8_STAGE(PG8_SB(0, 1), cB + hstep, voffB); PG8_STAGE(PG8_SA(0, 1), cA + hstep, voffA);
        if (wr == 1) PG8_BAR;
        PG8_WAIT_V(4); PG8_BAR;
        PG8_STAGE(PG8_SB(1, 0), cB + kstep, voffB); PG8_STAGE(PG8_SA(1, 0), cA + kstep, voffA); PG8_STAGE(PG8_SB(1, 1), cB + hstep + kstep, voffB);
        PG8_WAIT_V(6); PG8_BAR;
    }
    for (;;) {
        const bool has_next = S.next(ui + 1, nxt);
        const char* nA = has_next ? (const char*)g.A + (size_t)nxt.pm * tstep : cA; const char* nB = has_next ? (const char*)g.Bt + (size_t)nxt.pn * tstep : cB;
        for (int t = 0; t < nt; t += 2) {
            const bool last = (t == nt - 2);
            const char* a1 = cA + (size_t)(t + 1) * kstep;
            const char* a2 = last ? nA : cA + (size_t)(t + 2) * kstep; const char* b2 = last ? nB : cB + (size_t)(t + 2) * kstep;
            const char* a3 = a2 + kstep; const char* b3 = b2 + kstep;
            if (last && has_next) S.a_ready(nxt);
            if constexpr (SP2) {
            PG8_LDB(B0, 0, 0); PG8_LDB(B1, 0, 1); PG8_SCHED; PG8_LDA(At, 0, 0); PG8_STAGE(PG8_SA(1, 1), a1 + hstep, voffA);
            PG8_WAIT_V(8); PG8_WAIT_L(0); PG8_BAR; PG8_MMA(0, 0, At, B0); PG8_MMA(0, 1, At, B1); PG8_BAR; PG8_SCHED;
            PG8_LDA(At, 0, 1); PG8_STAGE(PG8_SB(0, 0), b2, voffB); PG8_STAGE(PG8_SB(0, 1), b2 + hstep, voffB); PG8_STAGE(PG8_SA(0, 0), a2, voffA);
            PG8_WAIT_V(8); PG8_WAIT_L(0); PG8_BAR; PG8_MMA(1, 0, At, B0); PG8_MMA(1, 1, At, B1); PG8_BAR; PG8_SCHED;
            PG8_LDB(B0, 1, 0); PG8_LDB(B1, 1, 1); PG8_SCHED; PG8_LDA(At, 1, 0); PG8_STAGE(PG8_SA(0, 1), a2 + hstep, voffA);
            PG8_WAIT_V(8); PG8_WAIT_L(0); PG8_BAR; PG8_MMA(0, 0, At, B0); PG8_MMA(0, 1, At, B1); PG8_BAR; PG8_SCHED;
            PG8_LDA(At, 1, 1); PG8_STAGE(PG8_SB(1, 0), b3, voffB); PG8_STAGE(PG8_SB(1, 1), b3 + hstep, voffB); PG8_STAGE(PG8_SA(1, 0), a3, voffA);
            PG8_WAIT_V(8); PG8_WAIT_L(0); PG8_BAR; PG8_MMA(1, 0, At, B0); PG8_MMA(1, 1, At, B1); PG8_BAR; PG8_SCHED;
            } else {
            PG8_LDB(B0, 0, 0); PG8_SCHED; PG8_LDA(At, 0, 0); PG8_STAGE(PG8_SA(1, 1), a1 + hstep, voffA);
            PG8_WAIT_L(8); PG8_BAR; PG8_WAIT_L(0); PG8_MMA(0, 0, At, B0); PG8_BAR; PG8_SCHED;
            PG8_LDB(B1, 0, 1); PG8_STAGE(PG8_SB(0, 0), b2, voffB);
            PG8_BAR; PG8_WAIT_L(0); PG8_MMA(0, 1, At, B1); PG8_BAR;
            PG8_LDA(At, 0, 1); PG8_STAGE(PG8_SA(0, 0), a2, voffA);
            PG8_BAR; PG8_WAIT_L(0); PG8_MMA(1, 0, At, B0); PG8_BAR; PG8_SCHED;
            PG8_STAGE(PG8_SB(0, 1), b2 + hstep, voffB);
            PG8_WAIT_V(6); PG8_BAR; PG8_MMA(1, 1, At, B1); PG8_BAR;
            PG8_LDB(B0, 1, 0); PG8_SCHED; PG8_LDA(At, 1, 0); PG8_STAGE(PG8_SA(0, 1), a2 + hstep, voffA);
            PG8_WAIT_L(8); PG8_BAR; PG8_WAIT_L(0); PG8_MMA(0, 0, At, B0); PG8_BAR; PG8_SCHED;
            PG8_LDB(B1, 1, 1); PG8_STAGE(PG8_SB(1, 0), b3, voffB);
            PG8_BAR; PG8_WAIT_L(0); PG8_MMA(0, 1, At, B1); PG8_BAR;
            PG8_LDA(At, 1, 1); PG8_STAGE(PG8_SA(1, 0), a3, voffA);
            PG8_BAR; PG8_WAIT_L(0); PG8_MMA(1, 0, At, B0); PG8_BAR; PG8_SCHED;
            PG8_STAGE(PG8_SB(1, 1), b3 + hstep, voffB);
            PG8_WAIT_V(6); PG8_BAR; PG8_MMA(1, 1, At, B1); PG8_BAR;
            }
        }
        if constexpr (ALIGN_EPI) { if (wr == 0) PG8_BAR; }
        if constexpr (!Epi::AFTER_DRAIN) { E(acc, cur, wr, wc, fr, fq); S.done(cur); }
        if (!has_next) break;
#pragma unroll
        for (int a = 0; a < 2; ++a)
#pragma unroll
            for (int b = 0; b < 2; ++b)
#pragma unroll
                for (int m = 0; m < 4; ++m)
#pragma unroll
                    for (int n = 0; n < 2; ++n) acc[a][b][m][n] = (f32x4){0.f, 0.f, 0.f, 0.f};
        cur = nxt; cA = nA; cB = nB; ++ui;
        if constexpr (ALIGN_EPI) { if (wr == 1) PG8_BAR; }
    }
    PG8_WAIT_V(0);
    if constexpr (!ALIGN_EPI) { if (wr == 0) PG8_BAR; }
    PG8_BAR;
    if constexpr (Epi::AFTER_DRAIN) { E.fused(acc, cur, wr, wc, fr, fq, lds, wid, lane); S.done(cur); }
#undef PG8_SA
#undef PG8_SB
#undef PG8_STAGE
#undef PG8_LDA
#undef PG8_LDB
#undef PG8_MMA
#undef PG8_WAIT_V
#undef PG8_WAIT_L
#undef PG8_BAR
#undef PG8_SCHED
}
}
#include <hip/hip_bf16.h>
#include <cmath>
namespace moba_body {
using bf16=__hip_bfloat16;
using bf16x8=__attribute__((ext_vector_type(8)))short;
using s16x4=__attribute__((ext_vector_type(4)))short;
using f32x16=__attribute__((ext_vector_type(16)))float;
using u32x4=__attribute__((ext_vector_type(4)))unsigned;
using f32x4_t=__attribute__((ext_vector_type(4)))float;
constexpr int BATCH=8,NHEAD=8,SEQ=2048,D=64,DM=4608,DMO=1024;
constexpr int NW=8,QBLK=32,QB=QBLK*NW,KVBLK=64,NQB=SEQ/QB;
constexpr int ATTN_PITCH=DM, ATTN_UNIT_ROWS=QB;
__device__ __forceinline__ int crow(int r,int hi){return (r&3)+8*(r>>2)+4*hi;}
#define SBAR() __builtin_amdgcn_sched_barrier(0)
__device__ __forceinline__ void cmask(f32x16&p0,f32x16&p1,int jb,int qrel,int hi){
  const float NEG=-INFINITY; int kb=64*jb+4*hi;
  #pragma unroll
  for(int r=0;r<16;++r){int kv=kb+(r&3)+8*(r>>2); if(kv>qrel)p0[r]=NEG; if(kv+32>qrel)p1[r]=NEG;}
}

constexpr int NSLOT=3, SLOTB=8192;
constexpr int LDS_K=0, LDS_V=NSLOT*SLOTB, LDS_WS=2*NSLOT*SLOTB, LDS_OST=LDS_WS+NW*64*4, LDS_BYTES=LDS_OST+NW*4096;
constexpr float C2=0.125f*1.4426950408889634f;
__device__ __forceinline__ void glds16(const void*gsrc,unsigned lds_dst){unsigned keep;
  asm volatile("s_mov_b32 %0, m0\n\ts_mov_b32 m0, %2\n\ts_nop 0\n\tglobal_load_lds_dwordx4 %1, off\n\ts_mov_b32 m0, %0":"=&s"(keep):"v"(gsrc),"s"(lds_dst):"memory");}
__device__ __forceinline__ float max3f(float a,float b,float c){float r;asm("v_max3_f32 %0, %1, %2, %3":"=v"(r):"v"(a),"v"(b),"v"(c));return r;}
__device__ __forceinline__ float max2f(float a,float b){float r;asm("v_max_f32_e32 %0, %1, %2":"=v"(r):"v"(a),"v"(b));return r;}
__device__ __forceinline__ float fadd_s(float a,float b){float r;asm("v_add_f32_e32 %0, %1, %2":"=v"(r):"v"(a),"v"(b));return r;}
__device__ __forceinline__ float fsub_s(float a,float b){float r;asm("v_sub_f32_e32 %0, %1, %2":"=v"(r):"v"(a),"v"(b));return r;}
typedef float f32x2_t __attribute__((ext_vector_type(2))); typedef __bf16 bf16x2_t __attribute__((ext_vector_type(2)));
__device__ __forceinline__ unsigned cvtpk_s(float lo,float hi){f32x2_t v={lo,hi};bf16x2_t b=__builtin_convertvector(v,bf16x2_t);return __builtin_bit_cast(unsigned,b);}
#define WAIT_BAR(N) asm volatile("s_waitcnt vmcnt(" #N ") lgkmcnt(0)\n\ts_barrier":::"memory")

__device__ __forceinline__ void qkt(f32x16&p0,f32x16&p1,const char*Kslot,const bf16x8*qr,const f32x16&negm,int r32,int hi){
  const char*kb=Kslot+hi*1024+r32*16;
  #pragma unroll
  for(int d0=0;d0<4;++d0){
    const bf16x8 b0=*reinterpret_cast<const bf16x8*>(kb+d0*2048);
    const bf16x8 b1=*reinterpret_cast<const bf16x8*>(kb+d0*2048+512);
    if(d0==0){p0=__builtin_amdgcn_mfma_f32_32x32x16_bf16(b0,qr[0],negm,0,0,0);p1=__builtin_amdgcn_mfma_f32_32x32x16_bf16(b1,qr[0],negm,0,0,0);}
    else{p0=__builtin_amdgcn_mfma_f32_32x32x16_bf16(b0,qr[d0],p0,0,0,0);p1=__builtin_amdgcn_mfma_f32_32x32x16_bf16(b1,qr[d0],p1,0,0,0);}}
}
typedef __attribute__((address_space(3))) const char* lds_cptr;
typedef short v4i16_t __attribute__((ext_vector_type(4)));
__device__ __forceinline__ void kload8(bf16x8*kf,lds_cptr kp){
  kf[0]=*(const __attribute__((address_space(3))) bf16x8*)(kp);      kf[1]=*(const __attribute__((address_space(3))) bf16x8*)(kp+512);
  kf[2]=*(const __attribute__((address_space(3))) bf16x8*)(kp+2048); kf[3]=*(const __attribute__((address_space(3))) bf16x8*)(kp+2560);
  kf[4]=*(const __attribute__((address_space(3))) bf16x8*)(kp+4096); kf[5]=*(const __attribute__((address_space(3))) bf16x8*)(kp+4608);
  kf[6]=*(const __attribute__((address_space(3))) bf16x8*)(kp+6144); kf[7]=*(const __attribute__((address_space(3))) bf16x8*)(kp+6656);
}
__device__ __forceinline__ void kload2(bf16x8*kf,lds_cptr kp,int j){ kf[2*j]=*(const __attribute__((address_space(3))) bf16x8*)(kp+j*2048); kf[2*j+1]=*(const __attribute__((address_space(3))) bf16x8*)(kp+j*2048+512); }
__device__ __forceinline__ s16x4 vtr(lds_cptr p){ return __builtin_bit_cast(s16x4,__builtin_amdgcn_ds_read_tr16_b64_v4i16((__attribute__((address_space(3))) v4i16_t*)p)); }
__device__ __forceinline__ float rowmax(const f32x16&p0,const f32x16&p1){
  float a=max3f(p0[0],p0[1],p1[0]),b=max3f(p0[2],p0[3],p1[1]);a=max3f(a,p1[2],p1[3]);
  #pragma unroll
  for(int r=4;r<16;r+=4){a=max3f(a,p0[r],p0[r+1]);b=max3f(b,p0[r+2],p0[r+3]);a=max3f(a,p1[r],p1[r+1]);b=max3f(b,p1[r+2],p1[r+3]);}
  const float m=max2f(a,b);
  auto rr=__builtin_amdgcn_permlane32_swap(__float_as_uint(m),__float_as_uint(m),false,false);
  return max2f(__uint_as_float(rr[0]),__uint_as_float(rr[1]));
}
__device__ __forceinline__ void pv(f32x16*o,int vb,bf16x8 pa0,bf16x8 pa1,bf16x8 pa2,bf16x8 pa3){
  #pragma unroll
  for(int d0=0;d0<2;++d0){s16x4 lo[4],hi[4];
    #pragma unroll
    for(int ks=0;ks<4;++ks){
      asm volatile("ds_read_b64_tr_b16 %0,%1 offset:%c2":"=&v"(lo[ks]):"v"(vb),"i"(d0*4096+ks*1024):"memory");
      asm volatile("ds_read_b64_tr_b16 %0,%1 offset:%c2":"=&v"(hi[ks]):"v"(vb),"i"(d0*4096+ks*1024+512):"memory");}
    asm volatile("s_waitcnt lgkmcnt(0)":::"memory");SBAR();
    #define PK(k) (bf16x8){lo[k][0],lo[k][1],lo[k][2],lo[k][3],hi[k][0],hi[k][1],hi[k][2],hi[k][3]}
    o[d0]=__builtin_amdgcn_mfma_f32_32x32x16_bf16(pa0,PK(0),o[d0],0,0,0);
    o[d0]=__builtin_amdgcn_mfma_f32_32x32x16_bf16(pa1,PK(1),o[d0],0,0,0);
    o[d0]=__builtin_amdgcn_mfma_f32_32x32x16_bf16(pa2,PK(2),o[d0],0,0,0);
    o[d0]=__builtin_amdgcn_mfma_f32_32x32x16_bf16(pa3,PK(3),o[d0],0,0,0);
    #undef PK
  }
}

#ifndef ATTN_STORE16
#define ATTN_STORE16(p,v) (*(u32x4*)(p)=(v))
#endif
template<int THRL> __device__ __forceinline__ void attn_unit(int b,int h,int qb,const bf16*Q,const bf16*__restrict__ K,const bf16*__restrict__ V,const bf16*__restrict__ Z,bf16*O,const float*__restrict__ kmean,char*shm){
  const int tid=threadIdx.x,lane=tid&63,r32=lane&31,hi=lane>>5; const int wid=__builtin_amdgcn_readfirstlane(tid>>6);
  const long rowbase=(long)b*SEQ; const int q0=qb*QB;
  const bf16*Qw=Q+(rowbase+q0+wid*QBLK)*DM+h*D;
  const bf16*Kh=K+rowbase*DM+h*D,*Vh=V+rowbase*DM+h*D;
  const unsigned lds0=(unsigned)(uintptr_t)shm;
  float*wsf=(float*)(shm+LDS_WS)+wid*64;
  const bf16*ksrc=Kh+(long)lane*DM+wid*8;
  const bf16*vsrc=Vh+(long)(16*(wid&3)+(lane>>2))*DM+(wid>>2)*32+(lane&3)*8;
  const unsigned kdst=lds0+LDS_K+wid*1024, vdst=lds0+LDS_V+wid*1024;
  #define DMA_K(t,slot) glds16(ksrc+(long)(t)*KVBLK*DM,(unsigned)__builtin_amdgcn_readfirstlane(kdst+(slot)))
  #define DMA_V(t,slot) glds16(vsrc+(long)(t)*KVBLK*DM,(unsigned)__builtin_amdgcn_readfirstlane(vdst+(slot)))
  const int vb0=(int)(lds0+LDS_V)+((lane>>4)&1)*32+(lane&3)*8+(4*hi+((lane&15)>>2))*64;
  const char*Kbase=shm+LDS_K; bf16x8 kf[8];
  const lds_cptr shm3=(lds_cptr)shm; const lds_cptr kp0=shm3+LDS_K+hi*1024+r32*16; const lds_cptr vp0=shm3+LDS_V+((lane>>4)&1)*32+(lane&3)*8+(4*hi+((lane&15)>>2))*64;
  const int NT=(q0+QB)/KVBLK;
  DMA_K(0,0);DMA_V(0,0);DMA_K(1,SLOTB);
  bf16x8 qr[4];
  #pragma unroll
  for(int d0=0;d0<4;++d0)qr[d0]=*reinterpret_cast<const bf16x8*>(&Qw[(long)r32*DM+d0*16+hi*8]);
  float mhat=0.f,l_reg=0.f;f32x16 o[2];o[0]=f32x16{};o[1]=f32x16{};f32x16 negm;
  const int qrel=wid*QBLK+r32;
  const float slope2=__builtin_amdgcn_exp2f(-(float)(h+1))*1.4426950408889634f;
  unsigned selmask=0xFFu;
  if(qb>=4){
    float g[7];
    #pragma unroll
    for(int n=0;n<7;++n){ float a=-INFINITY;
      if(n<qb){ a=0.f; const float*km=kmean+n*64+hi*8;
        #pragma unroll
        for(int d0=0;d0<4;++d0){ const f32x4_t k0=*(const f32x4_t*)(km+d0*16),k1=*(const f32x4_t*)(km+d0*16+4);
          #pragma unroll
          for(int jj=0;jj<4;++jj){ a+=__uint_as_float(((unsigned)(unsigned short)qr[d0][jj])<<16)*k0[jj]; a+=__uint_as_float(((unsigned)(unsigned short)qr[d0][4+jj])<<16)*k1[jj]; } }
        a+=__shfl_xor(a,32); }
      g[n]=a; }
    unsigned m_=1u<<qb;
    #pragma unroll
    for(int n=0;n<7;++n){ int rank=0;
      #pragma unroll
      for(int mm=0;mm<7;++mm){ if(mm!=n) rank+=((g[mm]>g[n])||(g[mm]==g[n]&&mm<n))?1:0; }
      if(n<qb&&rank<3) m_|=1u<<n; }
    selmask=m_;
  }
  #define NEGM_SET(tt) do{ const float tb_=slope2*(float)(64*(tt)-q0+4*hi); const float mr_=((selmask>>((tt)>>2))&1u)?(tb_-mhat):-INFINITY; \
    _Pragma("unroll") for(int r=0;r<16;++r)negm[r]=__builtin_fmaf(slope2,(float)((r&3)+8*(r>>2)),mr_); asm volatile("":"+v"(negm)); }while(0)
  #define BIAS1(P1) do{ _Pragma("unroll") for(int r=0;r<16;++r)P1[r]+=32.f*slope2; }while(0)
  #define CMASK(P0,P1,t) do{int jb_=(t)-(NT-4); if(jb_>=0)cmask(P0,P1,jb_,qrel,hi);}while(0)
  bool resc=false;
  #define START(P0,P1) do{ const float rm=rowmax(P0,P1); resc=false; \
    { const float dl=(rm==-INFINITY)?0.f:rm; mhat=fadd_s(mhat,dl); \
      _Pragma("unroll") for(int r=0;r<16;++r){P0[r]=fsub_s(P0[r],dl);P1[r]=fsub_s(P1[r],dl);} } \
    _Pragma("unroll") for(int r=0;r<16;++r)P0[r]=__builtin_amdgcn_exp2f(P0[r]); }while(0)
  #define RESC() do{ if(resc){ asm volatile("s_waitcnt lgkmcnt(0)":::"memory"); \
      _Pragma("unroll") for(int d_=0;d_<2;++d_) _Pragma("unroll") for(int r=0;r<16;++r)o[d_][r]*=wsf[crow(r,hi)]; } }while(0)
  f32x16 pA0,pA1,pB0,pB1;
  int sl_prev=0,sl_cur=0,sl_next=SLOTB;
  #define ROT() do{sl_prev=sl_cur;sl_cur=sl_next;sl_next=(sl_next==(NSLOT-1)*SLOTB)?0:sl_next+SLOTB;}while(0)
  DMA_K(2,2*SLOTB);
  WAIT_BAR(3);
  NEGM_SET(0);
  qkt(pA0,pA1,Kbase,qr,negm,r32,hi);asm volatile("s_nop 15\n\ts_nop 7":"+v"(pA0),"+v"(pA1));BIAS1(pA1);CMASK(pA0,pA1,0);
  START(pA0,pA1);
  _Pragma("unroll") for(int r=0;r<16;++r)pA1[r]=__builtin_amdgcn_exp2f(pA1[r]);
  WAIT_BAR(0);
  DMA_K(3,0);DMA_V(1,SLOTB);
  ROT();
  kload8(kf,kp0+sl_cur);
  WAIT_BAR(2);
  s16x4 vlo[8],vhi[8]; u32x4 pw0,pw1,pw2,pw3;
  #define PKW(P,B) cvtpk_s(P[B],P[B+1])
  #define PAF(k) __builtin_bit_cast(bf16x8,pw##k)
  #define VFR(i) (bf16x8){vlo[i][0],vlo[i][1],vlo[i][2],vlo[i][3],vhi[i][0],vhi[i][1],vhi[i][2],vhi[i][3]}
  #define PIN(x) asm volatile("":"+v"(x))
  #define MX3(a,b,c) __builtin_fmaxf(__builtin_fmaxf((a),(b)),(c))
  #define GAPA(MF,A0,A1,A2,A3,W0,W1,PW) do{ MF; sacc+=A0; sacc+=A1; sacc+=A2; sacc+=A3; PIN(sacc); W0; W1; PIN(PW); SBAR(); }while(0)
  #define EX(v) __builtin_amdgcn_exp2f(v)
  #define GAPB(MF,X,B) do{ MF; X[B]=EX(X[B]); X[B+1]=EX(X[B+1]); X[B+2]=EX(X[B+2]); X[B+3]=EX(X[B+3]); PIN(X); SBAR(); }while(0)
  #define VRD(i) do{ vlo[i]=vtr(vp_+(((i)>>2)*4096+((i)&3)*1024)); vhi[i]=vtr(vp_+(((i)>>2)*4096+((i)&3)*1024+512)); }while(0)
  #define KRD(G,j) do{ if(G){ kload2(kf,kp0+sl_next,j); SBAR(); } }while(0)
  #define STEP(C0,C1,P0,P1,t,GK,GV,GL) do{ SBAR(); NEGM_SET(t); SBAR(); \
    const lds_cptr vp_=vp0+sl_prev; \
    VRD(0); SBAR(); float sacc=(P0[0]+P0[1]); \
    GAPA(C0=__builtin_amdgcn_mfma_f32_32x32x16_bf16(kf[0],qr[0],negm,0,0,0), P0[2],P0[3],P0[4],P0[5],     pw0[0]=PKW(P0,0), pw0[1]=PKW(P0,2), pw0); \
    VRD(4); SBAR(); GAPA(C1=__builtin_amdgcn_mfma_f32_32x32x16_bf16(kf[1],qr[0],negm,0,0,0), P0[6],P0[7],P0[8],P0[9],     pw0[2]=PKW(P0,4), pw0[3]=PKW(P0,6), pw0); \
    VRD(1); SBAR(); GAPA(C0=__builtin_amdgcn_mfma_f32_32x32x16_bf16(kf[2],qr[1],C0,0,0,0),   P0[10],P0[11],P0[12],P0[13], pw1[0]=PKW(P0,8), pw1[1]=PKW(P0,10), pw1); \
    VRD(5); SBAR(); GAPA(C1=__builtin_amdgcn_mfma_f32_32x32x16_bf16(kf[3],qr[1],C1,0,0,0),   P0[14],P0[15],P1[0],P1[1],   pw1[2]=PKW(P0,12),pw1[3]=PKW(P0,14), pw1); \
    VRD(2); SBAR(); GAPA(C0=__builtin_amdgcn_mfma_f32_32x32x16_bf16(kf[4],qr[2],C0,0,0,0),   P1[2],P1[3],P1[4],P1[5],     pw2[0]=PKW(P1,0), pw2[1]=PKW(P1,2), pw2); \
    VRD(6); SBAR(); GAPA(C1=__builtin_amdgcn_mfma_f32_32x32x16_bf16(kf[5],qr[2],C1,0,0,0),   P1[6],P1[7],P1[8],P1[9],     pw2[2]=PKW(P1,4), pw2[3]=PKW(P1,6), pw2); \
    VRD(3); SBAR(); GAPA(C0=__builtin_amdgcn_mfma_f32_32x32x16_bf16(kf[6],qr[3],C0,0,0,0),   P1[10],P1[11],P1[12],P1[13], pw3[0]=PKW(P1,8), pw3[1]=PKW(P1,10), pw3); \
    VRD(7); SBAR(); GAPA(C1=__builtin_amdgcn_mfma_f32_32x32x16_bf16(kf[7],qr[3],C1,0,0,0),   P1[14],P1[15],0.f,0.f,       pw3[2]=PKW(P1,12),pw3[3]=PKW(P1,14), pw3); \
    l_reg+=sacc; \
    if(GK){DMA_K((t)+3,sl_cur);} if(GV){DMA_V((t)+1,sl_next);} \
    BIAS1(C1); CMASK(C0,C1,t); \
    { float a=MX3(C0[0],C0[1],C1[0]),b=MX3(C0[2],C0[3],C1[1]); a=MX3(a,C1[2],C1[3]); \
      _Pragma("unroll") for(int r=4;r<16;r+=4){a=MX3(a,C0[r],C0[r+1]);b=MX3(b,C0[r+2],C0[r+3]);a=MX3(a,C1[r],C1[r+1]);b=MX3(b,C1[r+2],C1[r+3]);} \
      float rm=__builtin_fmaxf(a,b); { auto rr=__builtin_amdgcn_permlane32_swap(__float_as_uint(rm),__float_as_uint(rm),false,false); rm=__builtin_fmaxf(__uint_as_float(rr[0]),__uint_as_float(rr[1])); } \
      resc=false; \
      if(__builtin_expect(__any(rm>(float)THRL),0)){ const float dl=__builtin_fmaxf(rm,0.f); mhat+=dl; \
        _Pragma("unroll") for(int r=0;r<16;++r){C0[r]-=dl;C1[r]-=dl;} \
        const float f=__builtin_amdgcn_exp2f(-dl); l_reg*=f; if(hi==0)wsf[r32]=f; resc=true; } } \
    SBAR(); \
    GAPB(o[0]=__builtin_amdgcn_mfma_f32_32x32x16_bf16(PAF(0),VFR(0),o[0],0,0,0), C0,0); \
    GAPB(o[1]=__builtin_amdgcn_mfma_f32_32x32x16_bf16(PAF(0),VFR(4),o[1],0,0,0), C0,4); \
    KRD(GL,0); GAPB(o[0]=__builtin_amdgcn_mfma_f32_32x32x16_bf16(PAF(1),VFR(1),o[0],0,0,0), C0,8); \
    KRD(GL,1); GAPB(o[1]=__builtin_amdgcn_mfma_f32_32x32x16_bf16(PAF(1),VFR(5),o[1],0,0,0), C0,12); \
    KRD(GL,2); GAPB(o[0]=__builtin_amdgcn_mfma_f32_32x32x16_bf16(PAF(2),VFR(2),o[0],0,0,0), C1,0); \
    KRD(GL,3); GAPB(o[1]=__builtin_amdgcn_mfma_f32_32x32x16_bf16(PAF(2),VFR(6),o[1],0,0,0), C1,4); \
    GAPB(o[0]=__builtin_amdgcn_mfma_f32_32x32x16_bf16(PAF(3),VFR(3),o[0],0,0,0), C1,8); \
    GAPB(o[1]=__builtin_amdgcn_mfma_f32_32x32x16_bf16(PAF(3),VFR(7),o[1],0,0,0), C1,12); \
    }while(0)
  int t=1;
  #undef CMASK
  #define CMASK(P0,P1,t) do{}while(0)
  for(;t+5<NT;t+=2){
    STEP(pB0,pB1,pA0,pA1,t,true,true,true);     WAIT_BAR(2); RESC(); ROT();
    STEP(pA0,pA1,pB0,pB1,t+1,true,true,true);   WAIT_BAR(2); RESC(); ROT();
  }
  #undef CMASK
  #define CMASK(P0,P1,t) do{int jb_=(t)-(NT-4); if(jb_>=0)cmask(P0,P1,jb_,qrel,hi);}while(0)
  #define ENDW(tt) do{ if((tt)+3<NT){WAIT_BAR(2);} else if((tt)+2<NT){WAIT_BAR(1);} else {WAIT_BAR(0);} }while(0)
  for(;t+1<NT;t+=2){
    STEP(pB0,pB1,pA0,pA1,t,(t+3<NT),(t+1<NT),(t+1<NT));       ENDW(t);   RESC(); ROT();
    STEP(pA0,pA1,pB0,pB1,t+1,(t+4<NT),(t+2<NT),(t+2<NT));     ENDW(t+1); RESC(); ROT();
  }
  STEP(pB0,pB1,pA0,pA1,NT-1,false,false,false); RESC();
  { float sacc=pB0[0]+pB0[1]; _Pragma("unroll") for(int r=2;r<16;++r)sacc+=pB0[r]; _Pragma("unroll") for(int r=0;r<16;++r)sacc+=pB1[r]; l_reg+=sacc;
    pw0=(u32x4){PKW(pB0,0),PKW(pB0,2),PKW(pB0,4),PKW(pB0,6)};pw1=(u32x4){PKW(pB0,8),PKW(pB0,10),PKW(pB0,12),PKW(pB0,14)};pw2=(u32x4){PKW(pB1,0),PKW(pB1,2),PKW(pB1,4),PKW(pB1,6)};pw3=(u32x4){PKW(pB1,8),PKW(pB1,10),PKW(pB1,12),PKW(pB1,14)};
    SBAR(); pv(o,vb0+sl_cur,PAF(0),PAF(1),PAF(2),PAF(3)); }
  #undef PKW
  #undef PAF
  #undef VFR
  #undef PIN
  #undef MX3
  #undef GAPA
  #undef GAPB
  #undef EX
  #undef VRD
  #undef KRD
  #undef STEP
  #undef ENDW
  {auto rr=__builtin_amdgcn_permlane32_swap(__float_as_uint(l_reg),__float_as_uint(l_reg),false,false);l_reg=__uint_as_float(rr[0])+__uint_as_float(rr[1]);}
  if(hi==0)wsf[32+r32]=l_reg;asm volatile("s_waitcnt lgkmcnt(0)":::"memory");
  float rli[16];
  #pragma unroll
  for(int r=0;r<16;++r)rli[r]=__builtin_amdgcn_rcpf(wsf[32+crow(r,hi)]);
  bf16*Ow=O+(rowbase+q0+wid*QBLK)*DMO+512+h*D; const bf16*Zw=Z+(rowbase+q0+wid*QBLK)*DM+h*D;
  { bf16*stg=(bf16*)(shm+LDS_OST)+wid*2048;
    #pragma unroll
    for(int r=0;r<16;++r){const int orow=crow(r,hi);
      #pragma unroll
      for(int d0=0;d0<2;++d0)stg[orow*64+d0*32+r32]=__float2bfloat16(o[d0][r]*rli[r]);}
    asm volatile("s_waitcnt lgkmcnt(0)":::"memory");
    #pragma unroll
    for(int i=0;i<4;++i){const int row=i*8+(lane>>3),ch=lane&7; const u32x4 v=*(const u32x4*)(stg+row*64+ch*8); const u32x4 z=*(const u32x4*)(Zw+(long)row*DM+ch*8); u32x4 w;
      #pragma unroll
      for(int e=0;e<4;++e){ const float zl=__uint_as_float(z[e]<<16),zh=__uint_as_float(z[e]&0xffff0000u),ol=__uint_as_float(v[e]<<16),oh=__uint_as_float(v[e]&0xffff0000u);
        w[e]=cvtpk_s(ol*zl/(1.f+__expf(-zl)),oh*zh/(1.f+__expf(-zh))); }
      ATTN_STORE16(Ow+(long)row*DMO+ch*8,w);} }
  asm volatile("s_waitcnt lgkmcnt(0)\n\ts_barrier":::"memory");
  #undef DMA_K
  #undef DMA_V
  #undef CMASK
  #undef START
  #undef RESC
  #undef ROT
  #undef NEGM_SET
  #undef BIAS1
}
constexpr int ATTN_LDS_BYTES=LDS_BYTES;
struct AttnTensors { const bf16* Q; const bf16* K; const bf16* V; const bf16* Z; bf16* O; const float* kmean; };
struct AttnUnit { int bh; int qb; };
struct StaticOrder {
  int vcu, G;
  __device__ __forceinline__ StaticOrder(int grid,int v):vcu(v),G(grid){}
  __device__ __forceinline__ bool next(int i,AttnUnit&u)const{ const int v=vcu+(i>>1)*G; if(v>=256)return false; const int s=v&3; u.bh=v>>2; u.qb=(i&1)?s:7-s; return true; }
};
template<class Sched,int THRL=8> __device__ __forceinline__ void attn_phase(char*lds,const AttnTensors&T,const Sched&S){
  AttnUnit u;
  for(int i=0;S.next(i,u);++i){ attn_unit<THRL>(u.bh/NHEAD,u.bh%NHEAD,u.qb,T.Q,T.K,T.V,T.Z,T.O,T.kmean+(size_t)u.bh*8*64,lds); }
}
#undef SBAR
#undef WAIT_BAR
}


constexpr int NWAVES = 8;
constexpr size_t MiB = 1u << 20;
constexpr size_t WS_CTL = 0, CTL_ZERO_BYTES = 1 * MiB;
constexpr size_t WS_WTIN = 1 * MiB;
constexpr size_t WS_WTOUT = 10 * MiB;
constexpr size_t WS_ADAP = 12 * MiB;
constexpr size_t WS_ADA = 14 * MiB;
constexpr size_t WS_KMEAN = 14 * MiB + 128 * 1024;
constexpr size_t WS_GN = 14 * MiB + 256 * 1024;
constexpr size_t WS_MSC = 14 * MiB + 384 * 1024;
constexpr size_t WS_GATES = 14 * MiB + 512 * 1024;
constexpr size_t WS_ROWSS = 15 * MiB;
constexpr size_t WS_MST = 16 * MiB;
constexpr size_t WS_H = 32 * MiB;
constexpr size_t WS_PROJ = 64 * MiB;
constexpr size_t WS_QKC = 208 * MiB;
constexpr size_t WS_SMALL = 240 * MiB;
constexpr size_t WS_END = 256 * MiB;
constexpr int CW_BAR = 4096;

constexpr int RING_BYTES = 131072;
constexpr int LDSCTL_OFF = RING_BYTES, MISC_OFF = LDSCTL_OFF + 320;
constexpr int LDS_BYTES = 147456;

#define GAS __attribute__((address_space(1)))
#define LAS __attribute__((address_space(3)))
typedef unsigned v4u __attribute__((ext_vector_type(4)));
typedef float f32x4 __attribute__((ext_vector_type(4)));
typedef short bf16x8 __attribute__((ext_vector_type(8)));
#define LDS_WAIT() asm volatile("s_waitcnt lgkmcnt(0)" ::: "memory")
#define VM_WAIT() asm volatile("s_waitcnt vmcnt(0)" ::: "memory")
__device__ __forceinline__ unsigned f2bf(float f) { unsigned u = __builtin_bit_cast(unsigned, f); return (u + 0x7fffu + ((u >> 16) & 1u)) >> 16; }
__device__ __forceinline__ unsigned pk2(float lo, float hi) { return f2bf(lo) | (f2bf(hi) << 16); }
__device__ __forceinline__ float bf2f(bf16_t h) { return __uint_as_float(((unsigned)h) << 16); }
__device__ __forceinline__ float siluf(float v) { return v / (1.0f + __expf(-v)); }
__device__ __forceinline__ float sigmoidf_(float v) { return 1.0f / (1.0f + __expf(-v)); }
__device__ __forceinline__ int orig_col(int np) { return np < 2048 ? np : np + 8; }

#define XB_TMO      128
#define XB_XCNT(j)  (256  + 64 * (j))
#define XB_XSUB(j)  (1280 + 64 * (j))
#define XB_XGEN(j)  (2304 + 64 * (j))
#define XB_TOP      3328
#define XB_TOPGEN   3392
#define XCD_BAR_WORDS 3456
#define XB_SPIN_CAP (1u << 18)
__device__ __forceinline__ unsigned xb_ld(unsigned* p)              { return __hip_atomic_load(p, __ATOMIC_RELAXED, __HIP_MEMORY_SCOPE_AGENT); }
__device__ __forceinline__ unsigned xb_add(unsigned* p, unsigned v) { return __hip_atomic_fetch_add(p, v, __ATOMIC_RELAXED, __HIP_MEMORY_SCOPE_AGENT); }
__device__ __forceinline__ unsigned xb_xcc_id() { return (unsigned)__builtin_amdgcn_s_getreg((3 << 11) | 20) & 0xFu; }
#define XB_SPIN(cond, bar) do { unsigned _sp = 0; while (cond) { __builtin_amdgcn_s_sleep(1); \
    if ((++_sp & 255u) == 0u) { if (xb_ld(&(bar)[XB_TMO])) break; if (_sp > XB_SPIN_CAP) { atomicAdd(&(bar)[XB_TMO], 1u); break; } } } } while (0)
struct XcdBarrier { unsigned* bar; unsigned x; volatile LAS unsigned* st; };
__device__ __forceinline__ XcdBarrier xcd_barrier_post(unsigned* bar, volatile LAS unsigned* st) {
    XcdBarrier b; b.bar = bar; b.x = xb_xcc_id(); b.st = st;
    if (threadIdx.x == 0) (void)xb_add(&bar[XB_XCNT(b.x)], 1u);
    return b;
}
__device__ __forceinline__ void xcd_barrier_complete(unsigned* bar, unsigned x, unsigned& nloc, unsigned& nx) {
    const unsigned G = gridDim.x * gridDim.y * gridDim.z;
    unsigned sum, cnt, mine, sp = 0u;
    for (;;) {
        sum = 0u; cnt = 0u; mine = 0u;
#pragma unroll
        for (unsigned j = 0; j < 16; ++j) { const unsigned c = xb_ld(&bar[XB_XCNT(j)]); sum += c; cnt += (c > 0u) ? 1u : 0u; mine = (j == x) ? c : mine; }
        if (sum == G) break;
        __builtin_amdgcn_s_sleep(1);
        if ((++sp & 255u) == 0u) { if (xb_ld(&bar[XB_TMO])) break; if (sp > XB_SPIN_CAP) { atomicAdd(&bar[XB_TMO], 1u); break; } }
    }
    nloc = mine > 0u ? mine : 1u; nx = cnt > 0u ? cnt : 1u;
}
__device__ __forceinline__ void xcd_barrier(const XcdBarrier& b) {
    asm volatile("s_waitcnt vmcnt(0)" ::: "memory");
    __syncthreads();
    if (threadIdx.x == 0) {
        unsigned* bar = b.bar;
        __builtin_amdgcn_s_waitcnt(0);
        unsigned nloc = b.st[0], nx = b.st[1];
        if (nloc == 0u) { xcd_barrier_complete(bar, b.x, nloc, nx); b.st[0] = nloc; b.st[1] = nx; }
        const unsigned old = xb_add(&bar[XB_XSUB(b.x)], 1u);
        const unsigned gen = old / nloc;
        if (old + 1u == (gen + 1u) * nloc) {
            __builtin_amdgcn_fence(__ATOMIC_RELEASE, "agent");
            asm volatile("s_waitcnt vmcnt(0)" ::: "memory");
            const unsigned og = xb_add(&bar[XB_TOP], 1u);
            const unsigned tg = og / nx;
            if (og + 1u == (tg + 1u) * nx) xb_add(&bar[XB_TOPGEN], 1u);
            else XB_SPIN(xb_ld(&bar[XB_TOPGEN]) == tg, bar);
            __builtin_amdgcn_fence(__ATOMIC_ACQUIRE, "agent");
            xb_add(&bar[XB_XGEN(b.x)], 1u);
            asm volatile("s_waitcnt vmcnt(0)" ::: "memory");
        } else {
            XB_SPIN(xb_ld(&bar[XB_XGEN(b.x)]) == gen, bar);
            __builtin_amdgcn_fence(__ATOMIC_ACQUIRE, "agent");
            asm volatile("s_waitcnt vmcnt(0)" ::: "memory");
        }
    }
    __syncthreads();
}

struct Frame {
    LAS unsigned char* lds;
    volatile LAS unsigned* MISC;
    int tid, lane, wave, vcu, G;
    const float *x, *c, *w_ada, *b_ada, *g_norm, *w_in, *conv_w, *conv_b, *b_ig, *b_fg, *g_head, *w_out, *g_final;
    float* out;
    unsigned char* ws;
};
__device__ __forceinline__ float wave_sum(float v) {
#pragma unroll
    for (int o = 1; o < 64; o <<= 1) v += __shfl_xor(v, o);
    return v;
}

namespace ml {
typedef short bf16x8 __attribute__((ext_vector_type(8)));
typedef float f32x4 __attribute__((ext_vector_type(4)));
typedef unsigned u32x2 __attribute__((ext_vector_type(2)));
typedef unsigned u32x4 __attribute__((ext_vector_type(4)));
#define MLAS __attribute__((address_space(3)))
constexpr int PQ = 136;
constexpr int PT = 72;
constexpr int L_QS = 0, L_KS = 17408, L_KT = 34816, L_VT = 53248, L_PS = 71680, L_CS = 80896, L_F32 = 115712;
constexpr int F_U = 0, F_M = 64, F_ISC = 128, F_EMT = 192, F_DENP = 256, F_NQ = 512, F_SSQ = 576, F_NV = 704;
__device__ __forceinline__ float bfbits(unsigned short h) { return __uint_as_float(((unsigned)h) << 16); }
__device__ __forceinline__ float lo16(unsigned w) { return __uint_as_float(w << 16); }
__device__ __forceinline__ float hi16(unsigned w) { return __uint_as_float(w & 0xffff0000u); }
__device__ __forceinline__ unsigned cvtpk(float lo, float hi) { typedef float f2 __attribute__((ext_vector_type(2))); typedef __bf16 b2 __attribute__((ext_vector_type(2))); f2 v = {lo, hi}; b2 r = __builtin_convertvector(v, b2); return __builtin_bit_cast(unsigned, r); }
__device__ __forceinline__ float silu_(float v) { return v / (1.0f + __expf(-v)); }
__device__ __forceinline__ float sigm_(float v) { return 1.0f / (1.0f + __expf(-v)); }
__device__ __forceinline__ int swz(int row, int chunk) { return ((chunk ^ ((row >> 3) & 7)) << 3); }

struct Ptrs { const bf16_t* proj; const float* gates; float* ftc; float* amc; float* gst; float* gn; float* gbmax; bf16_t* mix; };

template <bool OUT>
__device__ __forceinline__ void chunk_step(const Frame& F, const Ptrs& P, int b, int h, int c, float& mst, f32x4 (&Cacc)[8]) {
    MLAS unsigned char* L = F.lds;
    MLAS bf16_t* Qs = (MLAS bf16_t*)(L + L_QS); MLAS bf16_t* Ks = (MLAS bf16_t*)(L + L_KS); MLAS bf16_t* KT = (MLAS bf16_t*)(L + L_KT);
    MLAS bf16_t* VT = (MLAS bf16_t*)(L + L_VT); MLAS bf16_t* Ps = (MLAS bf16_t*)(L + L_PS); MLAS bf16_t* Cs = (MLAS bf16_t*)(L + L_CS);
    MLAS float* FS = (MLAS float*)(L + L_F32);
    int zz = 0; asm volatile("" : "+v"(zz));
    const int tid = F.tid | zz, lane = F.lane | zz, w = F.wave, lr = lane & 15, lq = lane >> 4;
    const int t0 = b * S_ + c * 64;
    const float ip = P.gates[(size_t)(t0 + lane) * 8 + h] + F.b_ig[h];
    const float fp = P.gates[(size_t)(t0 + lane) * 8 + 4 + h] + F.b_fg[h];
    const float lf = fminf(fp, 0.f) - log1pf(expf(-fabsf(fp)));
    float cum = lf;
#pragma unroll
    for (int o = 1; o < 64; o <<= 1) { const float t_ = __shfl_up(cum, o); if (lane >= o) cum += t_; }
    const float ft = __shfl(cum, 63);
    const float u = ip - cum;
    float pm = u;
#pragma unroll
    for (int o = 1; o < 64; o <<= 1) { const float t_ = __shfl_up(pm, o); if (lane >= o) pm = fmaxf(pm, t_); }
    const float am = ft + __shfl(pm, 63);
    const float mprev = mst;
    const float mnew = fmaxf(ft + mprev, am);
    const float s_old = expf(ft + mprev - mnew);
    const float wpr = expf(u + ft - mnew);
    if (OUT) { const float Mt = fmaxf(mprev, pm); if (w == 0) { FS[F_U + lane] = u; FS[F_M + lane] = Mt; FS[F_ISC + lane] = expf(mprev - Mt); FS[F_EMT + lane] = expf(-(cum + Mt)); } }
    else { if (w == 0 && lane == 0) { P.ftc[(b * 4 + h) * 32 + c] = ft; P.amc[(b * 4 + h) * 32 + c] = am; } }
#pragma unroll
    for (int i = (OUT ? 0 : 2); i < 6; ++i) {
        const int idx = (tid + 512 * i) & 1023, s = idx >> 4, dg = idx & 15;
        if (i >= 4) {
            const u32x4 raw = *(const u32x4*)(P.proj + (size_t)(t0 + s) * NP + OVM + h * 128 + 8 * dg);
            const int so = swz(8 * dg, s >> 3) + (s & 7);
#pragma unroll
            for (int e = 0; e < 4; ++e) { VT[(8 * dg + 2 * e) * PT + so] = (bf16_t)(raw[e] & 0xffffu); VT[(8 * dg + 2 * e + 1) * PT + so] = (bf16_t)(raw[e] >> 16); }
        } else {
            const int chb = (i >= 2 ? 512 : 0) + h * 128 + 8 * dg;
            float acc[8];
            { const f32x4 b0 = *(const f32x4*)(F.conv_b + chb), b1 = *(const f32x4*)(F.conv_b + chb + 4);
              acc[0] = b0[0]; acc[1] = b0[1]; acc[2] = b0[2]; acc[3] = b0[3]; acc[4] = b1[0]; acc[5] = b1[1]; acc[6] = b1[2]; acc[7] = b1[3]; }
#pragma unroll
            for (int tap = 0; tap < 4; ++tap) {
                const int sr = c * 64 + s - 3 + tap; const float ok = sr >= 0 ? 1.f : 0.f; const int srow = sr >= 0 ? sr : 0;
                const u32x4 raw = *(const u32x4*)(P.proj + (size_t)(b * S_ + srow) * NP + chb);
                const f32x4 w0 = *(const f32x4*)(F.conv_w + tap * 1024 + chb) * ok, w1 = *(const f32x4*)(F.conv_w + tap * 1024 + chb + 4) * ok;
                acc[0] += lo16(raw[0]) * w0[0]; acc[1] += hi16(raw[0]) * w0[1]; acc[2] += lo16(raw[1]) * w0[2]; acc[3] += hi16(raw[1]) * w0[3];
                acc[4] += lo16(raw[2]) * w1[0]; acc[5] += hi16(raw[2]) * w1[1]; acc[6] += lo16(raw[3]) * w1[2]; acc[7] += hi16(raw[3]) * w1[3];
            }
#pragma unroll
            for (int e = 0; e < 8; ++e) acc[e] = silu_(acc[e]);
            if (i < 2) {
                u32x4 o; o[0] = cvtpk(acc[0], acc[1]); o[1] = cvtpk(acc[2], acc[3]); o[2] = cvtpk(acc[4], acc[5]); o[3] = cvtpk(acc[6], acc[7]);
                *(MLAS u32x4*)(Qs + s * PQ + 8 * dg) = o;
            } else {
#pragma unroll
                for (int e = 0; e < 8; ++e) acc[e] *= 0.08838834764831845f;
                if (OUT) { u32x4 o; o[0] = cvtpk(acc[0], acc[1]); o[1] = cvtpk(acc[2], acc[3]); o[2] = cvtpk(acc[4], acc[5]); o[3] = cvtpk(acc[6], acc[7]);
                    *(MLAS u32x4*)(Ks + s * PQ + 8 * dg) = o; }
                const float ws_ = __shfl(wpr, s);
                const int so = swz(8 * dg, s >> 3) + (s & 7);
#pragma unroll
                for (int e = 0; e < 8; ++e) KT[(8 * dg + e) * PT + so] = (bf16_t)(cvtpk(acc[e] * ws_, 0.f) & 0xffffu);
            }
        }
    }
    __syncthreads();
    f32x4 yacc[4]; float isc = 0.f; int tt = w & 3, t = 16 * tt + lr;
    if (OUT) {
        f32x4 sacc[2]; sacc[0] = (f32x4){0.f, 0.f, 0.f, 0.f}; sacc[1] = sacc[0];
#pragma unroll
        for (int i = 0; i < 4; ++i) yacc[i] = (f32x4){0.f, 0.f, 0.f, 0.f};
#pragma unroll
        for (int ks = 0; ks < 4; ++ks) {
            const bf16x8 bq = *(const MLAS bf16x8*)(Qs + (16 * tt + lr) * PQ + 32 * ks + 8 * lq);
#pragma unroll
            for (int i = 0; i < 2; ++i) { const int st = 2 * (w >> 2) + i; const bf16x8 ak = *(const MLAS bf16x8*)(Ks + (16 * st + lr) * PQ + 32 * ks + 8 * lq);
                sacc[i] = __builtin_amdgcn_mfma_f32_16x16x32_bf16(ak, bq, sacc[i], 0, 0, 0); }
#pragma unroll
            for (int i = 0; i < 4; ++i) { const int vt = 4 * (w >> 2) + i; const bf16x8 ac = *(const MLAS bf16x8*)(Cs + (16 * vt + lr) * PQ + 32 * ks + 8 * lq);
                yacc[i] = __builtin_amdgcn_mfma_f32_16x16x32_bf16(ac, bq, yacc[i], 0, 0, 0); }
        }
        const float Mt = FS[F_M + t]; isc = FS[F_ISC + t];
#pragma unroll
        for (int i = 0; i < 2; ++i) { const int st = 2 * (w >> 2) + i; float pv[4], rs = 0.f;
#pragma unroll
            for (int r = 0; r < 4; ++r) { const int s = 16 * st + 4 * lq + r; const float e = (s <= t) ? __expf(FS[F_U + s] - Mt) : 0.f; pv[r] = sacc[i][r] * e; rs += pv[r]; }
            u32x2 o; o[0] = cvtpk(pv[0], pv[1]); o[1] = cvtpk(pv[2], pv[3]);
            *(MLAS u32x2*)(Ps + t * PT + 16 * st + 4 * lq) = o;
            rs += __shfl_xor(rs, 16); rs += __shfl_xor(rs, 32);
            if (lane < 16) FS[F_DENP + st * 64 + t] = rs; }
#pragma unroll
        for (int i = 0; i < 4; ++i) yacc[i] = yacc[i] * isc;
        { const int tq = tid >> 3, part = tid & 7; float a = 0.f;
          const bf16x8 q0 = *(const MLAS bf16x8*)(Qs + tq * PQ + 16 * part), q1 = *(const MLAS bf16x8*)(Qs + tq * PQ + 16 * part + 8);
#pragma unroll
          for (int e = 0; e < 8; ++e) { a += bfbits((unsigned short)q0[e]) * FS[F_NV + 16 * part + e]; a += bfbits((unsigned short)q1[e]) * FS[F_NV + 16 * part + 8 + e]; }
          a += __shfl_xor(a, 1); a += __shfl_xor(a, 2); a += __shfl_xor(a, 4);
          if (part == 0) FS[F_NQ + tq] = a; }
        __syncthreads();
#pragma unroll
        for (int ks = 0; ks < 2; ++ks) {
            const bf16x8 bp = *(const MLAS bf16x8*)(Ps + (16 * tt + lr) * PT + 32 * ks + 8 * lq);
#pragma unroll
            for (int i = 0; i < 4; ++i) { const int vrow = 16 * (4 * (w >> 2) + i) + lr; const bf16x8 av = *(const MLAS bf16x8*)(VT + vrow * PT + swz(vrow, 4 * ks + lq));
                yacc[i] = __builtin_amdgcn_mfma_f32_16x16x32_bf16(av, bp, yacc[i], 0, 0, 0); }
        }
        const float den = ((FS[F_DENP + t] + FS[F_DENP + 64 + t]) + (FS[F_DENP + 128 + t] + FS[F_DENP + 192 + t])) + isc * FS[F_NQ + t];
        const float inv = 1.0f / fmaxf(fabsf(den), FS[F_EMT + t]);
        float ssq = 0.f;
#pragma unroll
        for (int i = 0; i < 4; ++i) { yacc[i] = yacc[i] * inv; ssq += (yacc[i][0] * yacc[i][0] + yacc[i][1] * yacc[i][1]) + (yacc[i][2] * yacc[i][2] + yacc[i][3] * yacc[i][3]); }
        ssq += __shfl_xor(ssq, 16); ssq += __shfl_xor(ssq, 32);
        if (lane < 16) FS[F_SSQ + (w >> 2) * 64 + t] = ssq;
    }
#pragma unroll
    for (int vt = 0; vt < 8; ++vt) Cacc[vt] = Cacc[vt] * s_old;
#pragma unroll
    for (int ks = 0; ks < 2; ++ks) {
        const int krow = 16 * w + lr; const bf16x8 ak = *(const MLAS bf16x8*)(KT + krow * PT + swz(krow, 4 * ks + lq));
#pragma unroll
        for (int vt = 0; vt < 8; ++vt) { const int vrow = 16 * vt + lr; const bf16x8 bv = *(const MLAS bf16x8*)(VT + vrow * PT + swz(vrow, 4 * ks + lq));
            Cacc[vt] = __builtin_amdgcn_mfma_f32_16x16x32_bf16(ak, bv, Cacc[vt], 0, 0, 0); }
    }
    if (OUT) {
#pragma unroll
        for (int vt = 0; vt < 8; ++vt) { u32x2 o; o[0] = cvtpk(Cacc[vt][0], Cacc[vt][1]); o[1] = cvtpk(Cacc[vt][2], Cacc[vt][3]);
            *(MLAS u32x2*)(Cs + (16 * vt + lr) * PQ + 16 * w + 4 * lq) = o; }
    }
    if (tid < 128) { float a = 0.f;
#pragma unroll
        for (int ch = 0; ch < 8; ++ch) { const bf16x8 r = *(const MLAS bf16x8*)(KT + tid * PT + 8 * ch);
#pragma unroll
            for (int e = 0; e < 8; ++e) a += bfbits((unsigned short)r[e]); }
        FS[F_NV + tid] = s_old * FS[F_NV + tid] + a; }
    mst = mnew;
    if (OUT) {
        __syncthreads();
        const float rn = rsqrtf((FS[F_SSQ + t] + FS[F_SSQ + 64 + t]) * (1.0f / 128.0f) + 1e-6f);
#pragma unroll
        for (int i = 0; i < 4; ++i) { const int v0 = 16 * (4 * (w >> 2) + i) + 4 * lq;
            const f32x4 gh = *(const f32x4*)(F.g_head + h * 128 + v0);
            const u32x2 ov = *(const u32x2*)(P.proj + (size_t)(t0 + t) * NP + OOM + h * 128 + v0), zv = *(const u32x2*)(P.proj + (size_t)(t0 + t) * NP + OZM + h * 128 + v0);
            const float r0 = yacc[i][0] * rn * gh[0] * sigm_(lo16(ov[0])) * silu_(lo16(zv[0])), r1 = yacc[i][1] * rn * gh[1] * sigm_(hi16(ov[0])) * silu_(hi16(zv[0]));
            const float r2 = yacc[i][2] * rn * gh[2] * sigm_(lo16(ov[1])) * silu_(lo16(zv[1])), r3 = yacc[i][3] * rn * gh[3] * sigm_(hi16(ov[1])) * silu_(hi16(zv[1]));
            u32x2 o; o[0] = cvtpk(r0, r1); o[1] = cvtpk(r2, r3);
            *(u32x2*)(P.mix + (size_t)(t0 + t) * 1024 + h * 128 + v0) = o; }
    }
    __syncthreads();
}

__device__ __forceinline__ void m1_unit(const Frame& F, const Ptrs& P, int unit) {
    const int bh = unit >> 3, g = unit & 7, b = bh >> 2, h = bh & 3;
    if (g == 7) return;
    MLAS float* FS = (MLAS float*)(F.lds + L_F32);
    f32x4 Cacc[8];
#pragma unroll
    for (int vt = 0; vt < 8; ++vt) Cacc[vt] = (f32x4){0.f, 0.f, 0.f, 0.f};
    if (F.tid < 128) FS[F_NV + F.tid] = 0.f;
    float mst = -INFINITY;
    __syncthreads();
    for (int cc = 0; cc < 4; ++cc) chunk_step<false>(F, P, b, h, 4 * g + cc, mst, Cacc);
#pragma unroll
    for (int vt = 0; vt < 8; ++vt) *(f32x4*)(P.gst + ((((size_t)unit * 8 + F.wave) * 8 + vt) * 64 + F.lane) * 4) = Cacc[vt];
    if (F.tid < 128) P.gn[(size_t)unit * 128 + F.tid] = FS[F_NV + F.tid];
    if (F.tid == 0) P.gbmax[unit] = mst;
    __syncthreads();
}
__device__ __forceinline__ void m2_unit(const Frame& F, const Ptrs& P, int unit) {
    const int bh = unit >> 3, g = unit & 7, b = bh >> 2, h = bh & 3, c0 = 4 * g;
    MLAS unsigned char* L = F.lds; MLAS float* FS = (MLAS float*)(L + L_F32); MLAS bf16_t* Cs = (MLAS bf16_t*)(L + L_CS);
    float m = 0.f;
    for (int c = 0; c < c0; ++c) m = fmaxf(P.ftc[bh * 32 + c] + m, P.amc[bh * 32 + c]);
    f32x4 Cacc[8];
#pragma unroll
    for (int vt = 0; vt < 8; ++vt) Cacc[vt] = (f32x4){0.f, 0.f, 0.f, 0.f};
    float nacc = 0.f;
    for (int gp = 0; gp < g; ++gp) {
        float dec = 0.f;
        for (int c = 4 * (gp + 1); c < c0; ++c) dec += P.ftc[bh * 32 + c];
        const float coef = expf(dec + P.gbmax[bh * 8 + gp] - m);
        const size_t ug = (size_t)(bh * 8 + gp);
#pragma unroll
        for (int vt = 0; vt < 8; ++vt) Cacc[vt] += coef * *(const f32x4*)(P.gst + (((ug * 8 + F.wave) * 8 + vt) * 64 + F.lane) * 4);
        if (F.tid < 128) nacc += coef * P.gn[ug * 128 + F.tid];
    }
    if (F.tid < 128) FS[F_NV + F.tid] = nacc;
    { const int lr = F.lane & 15, lq = F.lane >> 4;
#pragma unroll
      for (int vt = 0; vt < 8; ++vt) { u32x2 o; o[0] = cvtpk(Cacc[vt][0], Cacc[vt][1]); o[1] = cvtpk(Cacc[vt][2], Cacc[vt][3]);
          *(MLAS u32x2*)(Cs + (16 * vt + lr) * PQ + 16 * F.wave + 4 * lq) = o; } }
    __syncthreads();
    for (int cc = 0; cc < 4; ++cc) chunk_step<true>(F, P, b, h, c0 + cc, m, Cacc);
}
__device__ __forceinline__ void kmean_item(const Frame& F, const bf16_t* proj, float* kmean, int item) {
    const int n = item & 7, hh = (item >> 3) & 7, b = item >> 6;
    MLAS float* part = (MLAS float*)F.lds;
    const int dgp = F.tid & 7, rg = F.tid >> 3;
    float a[8];
#pragma unroll
    for (int e = 0; e < 8; ++e) a[e] = 0.f;
#pragma unroll
    for (int r = 0; r < 4; ++r) { const u32x4 raw = *(const u32x4*)(proj + (size_t)(b * S_ + n * 256 + rg * 4 + r) * NP + OKB + hh * 64 + 8 * dgp);
#pragma unroll
        for (int e = 0; e < 4; ++e) { a[2 * e] += lo16(raw[e]); a[2 * e + 1] += hi16(raw[e]); } }
#pragma unroll
    for (int e = 0; e < 8; ++e) part[rg * 64 + 8 * dgp + e] = a[e];
    __syncthreads();
    if (F.tid < 64) { float s = 0.f;
#pragma unroll 8
        for (int r = 0; r < 64; ++r) s += part[r * 64 + F.tid];
        kmean[(size_t)item * 64 + F.tid] = s * (1.0f / 256.0f); }
    __syncthreads();
}
}
__device__ __forceinline__ void p0_transpose_item(const float* W, int ldw, bool remap, bf16_t* WT, LAS float* scr, int kb, int nb, int lane) {
    const int k0 = 64 * kb, n0 = 32 * nb; const int c0 = remap ? orig_col(n0) : n0;
#pragma unroll 8
    for (int i = 0; i < 32; ++i) { const int kk = 2 * i + (lane >> 5); scr[kk * 33 + (lane & 31)] = W[(size_t)(k0 + kk) * ldw + c0 + (lane & 31)]; }
    LDS_WAIT(); asm volatile("" ::: "memory");
    const int c = lane & 7;
#pragma unroll
    for (int j = 0; j < 4; ++j) { const int n = (lane >> 3) + 8 * j; const LAS float* s = scr + (8 * c) * 33 + n;
        v4u o; o.x = pk2(s[0 * 33], s[1 * 33]); o.y = pk2(s[2 * 33], s[3 * 33]); o.z = pk2(s[4 * 33], s[5 * 33]); o.w = pk2(s[6 * 33], s[7 * 33]);
        *(GAS v4u*)(WT + (size_t)(n0 + n) * 1024 + k0 + 8 * c) = o; }
    LDS_WAIT(); asm volatile("" ::: "memory");
}
__device__ __forceinline__ void p0_prologue(Frame& F) {
    LAS float* scr = (LAS float*)(F.lds + F.wave * 8448);
    LAS float* sc = (LAS float*)(F.lds + 69632);
    for (int e = F.tid; e < 8192; e += NWAVES * 64) { const int b = e >> 10, k = e & 1023; sc[k * 8 + b] = siluf(F.c[e]); }
    __syncthreads();
    const int gw = F.vcu * NWAVES + F.wave, NGW = F.G * NWAVES;
    constexpr int I_ADA = 48 * NKS, I_IN = 16 * (NP / 32), I_OUT = 16 * 32;
    float* adaP = (float*)(F.ws + WS_ADAP);
    bf16_t* WtIn = (bf16_t*)(F.ws + WS_WTIN); bf16_t* WtOut = (bf16_t*)(F.ws + WS_WTOUT);
    for (int it = gw; it < I_ADA + I_IN + I_OUT; it += NGW) {
        int r = it;
        if (r < I_ADA) {
            const int cg = r % 48, ks = r / 48, j = cg * 64 + F.lane;
            float acc[8];
#pragma unroll
            for (int b = 0; b < 8; ++b) acc[b] = 0.f;
            const float* wp = F.w_ada + (size_t)(ks * 64) * 3072 + j;
#pragma unroll 4
            for (int k = 0; k < 64; ++k) { const float w = wp[(size_t)k * 3072];
                const f32x4 s0 = *(const LAS f32x4*)(sc + (ks * 64 + k) * 8), s1 = *(const LAS f32x4*)(sc + (ks * 64 + k) * 8 + 4);
                acc[0] += s0[0] * w; acc[1] += s0[1] * w; acc[2] += s0[2] * w; acc[3] += s0[3] * w;
                acc[4] += s1[0] * w; acc[5] += s1[1] * w; acc[6] += s1[2] * w; acc[7] += s1[3] * w; }
#pragma unroll
            for (int b = 0; b < 8; ++b) adaP[((size_t)ks * 8 + b) * 3072 + j] = acc[b];
            continue;
        }
        r -= I_ADA;
        if (r < I_IN) { p0_transpose_item(F.w_in, NPROJ, true, WtIn, scr, r / (NP / 32), r % (NP / 32), F.lane); continue; }
        r -= I_IN;
        p0_transpose_item(F.w_out, 1024, false, WtOut, scr, r / 32, r % 32, F.lane);
    }
}

__device__ __forceinline__ void p1_norm(Frame& F) {
    LAS float* gs = (LAS float*)(F.lds); LAS float* sh = gs + 1024;
    const float* adaP = (const float*)(F.ws + WS_ADAP);
    float* ada = (float*)(F.ws + WS_ADA);
    if (true) { for (int e = blockIdx.x * (NWAVES * 64) + F.tid; e < 8 * 3072; e += F.G * NWAVES * 64) { float v = F.b_ada[e % 3072];
#pragma unroll
        for (int s = 0; s < NKS; ++s) v += adaP[(size_t)s * 8 * 3072 + e];
        ada[e] = v; } }
    bf16_t* H = (bf16_t*)(F.ws + WS_H); float* gates = (float*)(F.ws + WS_GATES);
    f32x4 wg[4][4][2];
#pragma unroll
    for (int j = 0; j < 4; ++j)
#pragma unroll
        for (int i = 0; i < 4; ++i) { const float* wp = F.w_in + (size_t)(4 * F.lane + 256 * j + i) * NPROJ + 2048; wg[j][i][0] = *(const f32x4*)wp; wg[j][i][1] = *(const f32x4*)(wp + 4); }
    for (int rb = F.vcu; rb < T_ / 64; rb += F.G) {
        const int r0 = 64 * rb, b = r0 / S_;
        for (int k = F.tid; k < 1024; k += NWAVES * 64) {
            float scl = F.b_ada[1024 + k], sft = F.b_ada[k];
#pragma unroll
            for (int s = 0; s < NKS; ++s) { scl += adaP[((size_t)s * 8 + b) * 3072 + 1024 + k]; sft += adaP[((size_t)s * 8 + b) * 3072 + k]; }
            gs[k] = F.g_norm[k] * (1.0f + scl); sh[k] = sft;
        }
        __syncthreads();
        f32x4 gsv[4], shv[4];
#pragma unroll
        for (int j = 0; j < 4; ++j) { gsv[j] = *(const LAS f32x4*)(gs + 4 * F.lane + 256 * j); shv[j] = *(const LAS f32x4*)(sh + 4 * F.lane + 256 * j); }
        for (int rr = 0; rr < 8; ++rr) {
            const int m = r0 + F.wave * 8 + rr;
            const GAS f32x4* xr = (const GAS f32x4*)(F.x + (size_t)m * D_) + F.lane;
            f32x4 v[4]; float s = 0.f;
#pragma unroll
            for (int j = 0; j < 4; ++j) { v[j] = xr[64 * j]; s += (v[j].x * v[j].x + v[j].y * v[j].y) + (v[j].z * v[j].z + v[j].w * v[j].w); }
            const float rstd = rsqrtf(wave_sum(s) * (1.f / D_) + 1e-6f);
            float ga[8];
#pragma unroll
            for (int c = 0; c < 8; ++c) ga[c] = 0.f;
            GAS unsigned long long* o8 = (GAS unsigned long long*)(H + (size_t)m * D_) + F.lane;
#pragma unroll
            for (int j = 0; j < 4; ++j) {
                f32x4 hv = v[j] * rstd * gsv[j] + shv[j];
                o8[64 * j] = (unsigned long long)pk2(hv.x, hv.y) | ((unsigned long long)pk2(hv.z, hv.w) << 32);
#pragma unroll
                for (int i = 0; i < 4; ++i)
#pragma unroll
                    for (int c = 0; c < 8; ++c) ga[c] += hv[i] * wg[j][i][c >> 2][c & 3];
            }
#pragma unroll
            for (int c = 0; c < 8; ++c) ga[c] = wave_sum(ga[c]);
            if (F.lane == 0) { *(f32x4*)(gates + (size_t)m * 8) = (f32x4){ga[0], ga[1], ga[2], ga[3]}; *(f32x4*)(gates + (size_t)m * 8 + 4) = (f32x4){ga[4], ga[5], ga[6], ga[7]}; }
        }
        __syncthreads();
    }
}

constexpr float QSCALE = 0.125f * 1.4426950408889634f;

__device__ __forceinline__ void p6_final(Frame& F) {
    const int gw = F.vcu * NWAVES + F.wave, NGW = F.G * NWAVES;
    const float* rowss = (const float*)(F.ws + WS_ROWSS);
    f32x4 gf[4];
#pragma unroll
    for (int j = 0; j < 4; ++j) gf[j] = *(const f32x4*)(F.g_final + 4 * F.lane + 256 * j);
    for (int m = gw; m < T_; m += NGW) {
        const f32x4* pr = (const f32x4*)(rowss + (size_t)m * 16);
        const f32x4 p0 = pr[0], p1 = pr[1], p2 = pr[2], p3 = pr[3];
        const float ss = ((p0[0] + p0[1]) + (p0[2] + p0[3])) + ((p1[0] + p1[1]) + (p1[2] + p1[3])) + ((p2[0] + p2[1]) + (p2[2] + p2[3])) + ((p3[0] + p3[1]) + (p3[2] + p3[3]));
        const float rstd = rsqrtf(ss * (1.f / D_) + 1e-6f);
        GAS f32x4* xr = (GAS f32x4*)(F.out + (size_t)m * D_) + F.lane;
#pragma unroll
        for (int j = 0; j < 4; ++j) { f32x4 v = xr[64 * j]; xr[64 * j] = v * rstd * gf[j]; }
    }
}

struct Args { const float* in[13]; float* out; unsigned char* ws; int ph_lo, ph_hi, li, pad; };
__global__ void __launch_bounds__(NWAVES * 64, 2) mk_fwd(Args args) {
    extern __shared__ __attribute__((aligned(16))) unsigned char lds[];
    Frame F;
    F.lds = (LAS unsigned char*)lds;
    F.MISC = (volatile LAS unsigned*)(F.lds + MISC_OFF);
    F.tid = threadIdx.x; F.lane = F.tid & 63; F.wave = __builtin_amdgcn_readfirstlane(F.tid >> 6);
    F.G = gridDim.x; { const int bx = blockIdx.x; F.vcu = (F.G % 8 == 0) ? (bx % 8) * (F.G / 8) + bx / 8 : bx; }
    F.x = args.in[0]; F.c = args.in[1]; F.w_ada = args.in[2]; F.b_ada = args.in[3]; F.g_norm = args.in[4]; F.w_in = args.in[5];
    F.conv_w = args.in[6]; F.conv_b = args.in[7]; F.b_ig = args.in[8]; F.b_fg = args.in[9]; F.g_head = args.in[10]; F.w_out = args.in[11]; F.g_final = args.in[12];
    F.out = args.out; F.ws = args.ws;
    for (int u = F.tid; u < (LDS_BYTES - LDSCTL_OFF) / 4; u += NWAVES * 64) ((LAS unsigned*)(F.lds + LDSCTL_OFF))[u] = 0u;
    __syncthreads();
    unsigned* ctl = (unsigned*)(F.ws + WS_CTL);
    XcdBarrier bar = xcd_barrier_post(ctl + CW_BAR + args.li * XCD_BAR_WORDS, F.MISC + 8);
    const int lo = args.ph_lo, hi = args.ph_hi;
#define IN(k) (lo <= (k) && (k) < hi)
#define BOTH(k) (IN(k) && IN((k) + 1))
    if (IN(0)) { p0_prologue(F); if (BOTH(0)) xcd_barrier(bar); }
    if (IN(1)) { p1_norm(F); if (BOTH(1)) xcd_barrier(bar); }
    if (IN(2)) {
        pg8::Gemm g{(const bf16_t*)(F.ws + WS_H), (const bf16_t*)(F.ws + WS_WTIN), T_, NP, D_};
        pg8::StaticOrder S; S.init(T_, NP, F.G, (int)blockIdx.x);
        pg8::EpiProj E{(bf16_t*)(F.ws + WS_PROJ), NP, OQB / 256, OKB / 256, QSCALE};
        pg8::gemm_phase<pg8::EpiProj, pg8::StaticOrder, true, true>(F.lds, g, S, E);
        if (BOTH(2)) xcd_barrier(bar);
    }
    ml::Ptrs MP{(const bf16_t*)(F.ws + WS_PROJ), (const float*)(F.ws + WS_GATES), (float*)(F.ws + WS_MSC), (float*)(F.ws + WS_MSC) + 1024, (float*)(F.ws + WS_MST),
                (float*)(F.ws + WS_GN), (float*)(F.ws + WS_MSC) + 2048, (bf16_t*)(F.ws + WS_H)};
    if (IN(3)) {
        for (int unit = F.vcu; unit < 256; unit += F.G) ml::m1_unit(F, MP, unit);
        for (int item = F.vcu; item < 512; item += F.G) ml::kmean_item(F, MP.proj, (float*)(F.ws + WS_KMEAN), item);
        if (BOTH(3)) xcd_barrier(bar);
    }
    if (IN(4)) {
        for (int unit = F.vcu; unit < 256; unit += F.G) ml::m2_unit(F, MP, unit);
        typedef moba_body::bf16 mb16;
        const moba_body::AttnTensors AT{(const mb16*)(F.ws + WS_PROJ) + OQB, (const mb16*)(F.ws + WS_PROJ) + OKB, (const mb16*)(F.ws + WS_PROJ) + OVB, (const mb16*)(F.ws + WS_PROJ) + OZB,
                                        (mb16*)(F.ws + WS_H), (const float*)(F.ws + WS_KMEAN)};
        const moba_body::StaticOrder S((int)F.G, F.vcu);
        moba_body::attn_phase<moba_body::StaticOrder>((char*)lds, AT, S);
        if (BOTH(4)) xcd_barrier(bar);
    }
    if (IN(5)) {
        pg8::Gemm g{(const bf16_t*)(F.ws + WS_H), (const bf16_t*)(F.ws + WS_WTOUT), T_, D_, D_};
        pg8::StaticOrder S; S.init(T_, D_, F.G, (int)blockIdx.x);
        pg8::EpiOut E{F.x, (const float*)(F.ws + WS_ADA), F.out, (float*)(F.ws + WS_ROWSS)};
        pg8::gemm_phase<pg8::EpiOut, pg8::StaticOrder, true, true>(F.lds, g, S, E);
        if (BOTH(5)) xcd_barrier(bar);
    }
    if (IN(6)) { p6_final(F); }
#undef IN
#undef BOTH
}

extern "C" void kernel_launch(void* const* d_in, const int* in_sizes, int n_in, void* d_out, int out_size,
                              void* d_ws, size_t ws_size, hipStream_t stream) {
  static int grid = 0;
  if (grid == 0) {
    int dev = 0, cus = 0, per_cu = 0;
    if (hipGetDevice(&dev) != hipSuccess || hipDeviceGetAttribute(&cus, hipDeviceAttributeMultiprocessorCount, dev) != hipSuccess) { grid = -1; return; }
    if (hipFuncSetAttribute((const void*)mk_fwd, hipFuncAttributeMaxDynamicSharedMemorySize, LDS_BYTES) != hipSuccess) { fprintf(stderr, "hipFuncSetAttribute failed\n"); grid = -1; return; }
    if (hipOccupancyMaxActiveBlocksPerMultiprocessor(&per_cu, (const void*)mk_fwd, NWAVES * 64, LDS_BYTES) != hipSuccess || per_cu < 1) { fprintf(stderr, "occupancy query: %d\n", per_cu); per_cu = 1; }
    (void)hipGetLastError();
    grid = cus;
    if (ws_size < WS_END) { fprintf(stderr, "workspace too small: %zu\n", ws_size); grid = -1; return; }
  }
  if (grid < 0) return;
  (void)hipMemsetAsync((char*)d_ws + WS_CTL, 0, CTL_ZERO_BYTES, stream);
  Args a{};
  for (int i = 0; i < 13; ++i) a.in[i] = (const float*)d_in[i];
  a.out = (float*)d_out; a.ws = (unsigned char*)d_ws; a.ph_lo = 0; a.ph_hi = 7; a.li = 0;
  hipLaunchKernelGGL(mk_fwd, dim3(grid), dim3(NWAVES * 64), LDS_BYTES, stream, a);
}
```
